# Optimizing an MI355X kernel written in HIP

```python
import math
import jax, jax.numpy as jnp
from jax import lax
import numpy as np

D_MODEL = 1024
BATCH = 4
SEQ = 8192
DEPTH = 2

CHUNK = 64
Q_BLOCK = 128
PLE_DIM = 256
MIX_WIDTH = D_MODEL // 2
POOL_WINDOWS = (2, 4, 8, 16)
POOL_GROUPS = len(POOL_WINDOWS)
POOL_GROUP_DIM = MIX_WIDTH // POOL_GROUPS
CONV_WIDTH = 3
ATTN_HEADS = 4
ATTN_HEAD_DIM = MIX_WIDTH // (2 * ATTN_HEADS)
ATTN_V_DIM = 2 * ATTN_HEAD_DIM
ATTN_QK_WIDTH = ATTN_HEADS * 2 * ATTN_HEAD_DIM
ATTN_V_WIDTH = ATTN_HEADS * ATTN_V_DIM
N_BRANCHES = 3
D_IN = 4 * MIX_WIDTH + 2 * ATTN_QK_WIDTH + ATTN_V_WIDTH + N_BRANCHES * D_MODEL
D_FF = 4 * D_MODEL
EPS = 1e-6
NEG_INF = -1e30

kernel_name = 'hybrid_pool_conv_diffattn_block'


def rms_norm(x, g):
    xf = x.astype(jnp.float32)
    y = xf * lax.rsqrt(jnp.mean(xf * xf, axis=-1, keepdims=True) + EPS)
    return (y * g.astype(jnp.float32)).astype(x.dtype)


def multiscale_pool(a, w, scale):
    b_, s_, _ = a.shape
    af = a.astype(jnp.float32).reshape(b_, s_, POOL_GROUPS, POOL_GROUP_DIM)
    cs = jnp.cumsum(af, axis=1)
    t = jnp.arange(s_)
    outs = []
    for g, win in enumerate(POOL_WINDOWS):
        csg = cs[:, :, g]
        prev = jnp.pad(csg, ((0, 0), (win, 0), (0, 0)))[:, :s_]
        cnt = jnp.minimum(t + 1, win).astype(jnp.float32)[None, :, None]
        outs.append((csg - prev) / cnt - af[:, :, g])
    pooled = jnp.stack(outs, axis=2)
    mixed = jnp.einsum('bsgc,gcd->bsgd', pooled, w.astype(jnp.float32))
    return (mixed.reshape(b_, s_, MIX_WIDTH) * scale.astype(jnp.float32)).astype(a.dtype)


def causal_depthwise_conv(z, w):
    c = z.shape[-1]
    return lax.conv_general_dilated(
        z, w[:, None, :].astype(z.dtype), window_strides=(1,),
        padding=[(CONV_WIDTH - 1, 0)], dimension_numbers=('NWC', 'WIO', 'NWC'),
        feature_group_count=c)


def diff_attention(q1, q2, k1, k2, v, lam):
    b_, s_, h_, d_ = q1.shape
    dv = v.shape[-1]
    nb = s_ // Q_BLOCK
    scale = d_ ** -0.5
    k1, k2, v = (t.transpose(0, 2, 1, 3) for t in (k1, k2, v))

    def to_blocks(q):
        return q.reshape(b_, nb, Q_BLOCK, h_, d_).transpose(1, 0, 3, 2, 4)

    key_chunk = jnp.arange(s_) // CHUNK

    def one_block(args):
        qb1, qb2, bi = args
        q_chunk = (bi * Q_BLOCK + jnp.arange(Q_BLOCK)) // CHUNK
        mask = key_chunk[None, :] <= q_chunk[:, None]

        def probs(q, k):
            s = jnp.einsum('bhqd,bhkd->bhqk', q, k).astype(jnp.float32) * scale
            return jax.nn.softmax(jnp.where(mask, s, NEG_INF), axis=-1)

        att = probs(qb1, k1) - lam * probs(qb2, k2)
        return jnp.einsum('bhqk,bhkd->bhqd', att.astype(v.dtype), v)

    out = lax.map(one_block, (to_blocks(q1), to_blocks(q2), jnp.arange(nb)))
    return out.transpose(1, 0, 3, 2, 4).reshape(b_, s_, h_, dv)


def setup_inputs(seed: int = 0) -> dict:
    key = jax.random.key(seed)
    ks = jax.random.split(key, 24)
    nrm = lambda k, shape, s: jax.random.normal(k, shape, jnp.float32) * s
    gain = lambda k, shape: 1.0 + 0.1 * jax.random.normal(k, shape, jnp.float32)
    L = DEPTH
    return {
        'x': nrm(ks[0], (BATCH, SEQ, D_MODEL), 1.0),
        'p': nrm(ks[1], (DEPTH, BATCH, SEQ, PLE_DIM), 1.0),
        'norm_mix_g': gain(ks[2], (L, D_MODEL)),
        'w_in': nrm(ks[3], (L, D_MODEL, D_IN), D_MODEL ** -0.5),
        'pool_w': nrm(ks[4], (L, POOL_GROUPS, POOL_GROUP_DIM, POOL_GROUP_DIM), POOL_GROUP_DIM ** -0.5),
        'pool_scale': gain(ks[5], (L, MIX_WIDTH)),
        'conv_w': nrm(ks[6], (L, CONV_WIDTH, MIX_WIDTH), CONV_WIDTH ** -0.5),
        'q_norm_g': gain(ks[7], (L, ATTN_HEAD_DIM)),
        'k_norm_g': gain(ks[8], (L, ATTN_HEAD_DIM)),
        'lam_q1': nrm(ks[9], (L, ATTN_HEAD_DIM), 0.1),
        'lam_k1': nrm(ks[10], (L, ATTN_HEAD_DIM), 0.1),
        'lam_q2': nrm(ks[11], (L, ATTN_HEAD_DIM), 0.1),
        'lam_k2': nrm(ks[12], (L, ATTN_HEAD_DIM), 0.1),
        'sub_norm_g': gain(ks[13], (L, ATTN_V_DIM)),
        'w_pool_out': nrm(ks[14], (L, MIX_WIDTH, D_MODEL), MIX_WIDTH ** -0.5),
        'w_conv_out': nrm(ks[15], (L, MIX_WIDTH, D_MODEL), MIX_WIDTH ** -0.5),
        'w_attn_out': nrm(ks[16], (L, ATTN_V_WIDTH, D_MODEL), ATTN_V_WIDTH ** -0.5),
        'w_o': nrm(ks[17], (L, D_MODEL, D_MODEL), D_MODEL ** -0.5),
        'norm_mlp_g': gain(ks[18], (L, D_MODEL)),
        'w_up': nrm(ks[19], (L, D_MODEL, D_FF), D_MODEL ** -0.5),
        'w_down': nrm(ks[20], (L, D_FF, D_MODEL), D_FF ** -0.5),
        'norm_ple_g': gain(ks[21], (L, D_MODEL)),
        'w_ple_gate': nrm(ks[22], (L, D_MODEL, D_MODEL), D_MODEL ** -0.5),
        'w_ple_proj': nrm(ks[23], (L, PLE_DIM, D_MODEL), PLE_DIM ** -0.5),
    }


def reference(x, p, norm_mix_g, w_in, pool_w, pool_scale, conv_w, q_norm_g, k_norm_g,
              lam_q1, lam_k1, lam_q2, lam_k2, sub_norm_g, w_pool_out, w_conv_out,
              w_attn_out, w_o, norm_mlp_g, w_up, w_down, norm_ple_g, w_ple_gate, w_ple_proj):
    b_, s_, _ = x.shape
    sizes = [MIX_WIDTH, MIX_WIDTH, MIX_WIDTH, MIX_WIDTH,
             ATTN_QK_WIDTH, ATTN_QK_WIDTH, ATTN_V_WIDTH]
    split_at = [int(c) for c in np.cumsum(sizes)]
    h = x
    for i in range(DEPTH):
        u = rms_norm(h, norm_mix_g[i])
        proj = u @ w_in[i]
        a_in, c_x, c_b, c_c, q, k, v, gates = jnp.split(proj, split_at, axis=-1)

        y_a = multiscale_pool(a_in, pool_w[i], pool_scale[i])

        y_b = c_b * causal_depthwise_conv(c_c * c_x, conv_w[i])

        q = q.reshape(b_, s_, ATTN_HEADS, 2, ATTN_HEAD_DIM)
        k = k.reshape(b_, s_, ATTN_HEADS, 2, ATTN_HEAD_DIM)
        v = v.reshape(b_, s_, ATTN_HEADS, ATTN_V_DIM)
        q1 = rms_norm(q[..., 0, :], q_norm_g[i])
        q2 = rms_norm(q[..., 1, :], q_norm_g[i])
        k1 = rms_norm(k[..., 0, :], k_norm_g[i])
        k2 = rms_norm(k[..., 1, :], k_norm_g[i])
        lam_init = 0.8 - 0.6 * math.exp(-0.3 * i)
        lam = (jnp.exp(jnp.sum(lam_q1[i].astype(jnp.float32) * lam_k1[i].astype(jnp.float32)))
               - jnp.exp(jnp.sum(lam_q2[i].astype(jnp.float32) * lam_k2[i].astype(jnp.float32)))
               + lam_init)
        o = diff_attention(q1, q2, k1, k2, v, lam)
        o = rms_norm(o, sub_norm_g[i]) * (1.0 - lam_init)
        y_c = o.reshape(b_, s_, ATTN_V_WIDTH)

        g_a, g_b, g_c = jnp.split(jax.nn.sigmoid(gates), N_BRANCHES, axis=-1)
        merged = (g_a * (y_a @ w_pool_out[i])
                  + g_b * (y_b @ w_conv_out[i])
                  + g_c * (y_c @ w_attn_out[i]))
        h = h + merged @ w_o[i]

        m = rms_norm(h, norm_mlp_g[i])
        h = h + jnp.square(jax.nn.relu(m @ w_up[i])) @ w_down[i]

        e = rms_norm(h, norm_ple_g[i])
        h = h + jax.nn.sigmoid(e @ w_ple_gate[i]) * (p[i] @ w_ple_proj[i])
    return h
```

```cpp
#include <hip/hip_runtime.h>
#include <cstdio>
#include <cstdint>
namespace pg8 {
#define PG8_LAS __attribute__((address_space(3)))
typedef unsigned short bf16_t;
typedef short bf16x8 __attribute__((ext_vector_type(8)));
typedef float f32x4 __attribute__((ext_vector_type(4)));
typedef unsigned u32x4 __attribute__((ext_vector_type(4)));
constexpr int BM = 256, BK = 64, HALF = 128, HTB = HALF * BK * 2  , STAGE_BYTES = 8 * HTB, NXCD = 8, WGM = 8;

__host__ __device__ __forceinline__ int lds_byte(int r, int c) { const int st = (r >> 4) * 2 + (c >> 5), rr = r & 15, cc = c & 31, ob = rr * 64 + cc * 2; return st * 1024 + (ob ^ (((ob >> 9) & 1) << 5)); }
__host__ __device__ __forceinline__ void stage_rc(int b, int& R, int& C) { const int st = b / 1024, sb = b % 1024, swz = sb ^ (((sb >> 9) & 1) << 5); R = (st >> 1) * 16 + swz / 64; C = (st & 1) * 32 + (swz % 64) / 2; }
__host__ __device__ __forceinline__ int perm32(int rho) { const int n = rho >> 4, i = rho & 15; return 8 * (i >> 2) + 4 * n + (i & 3); }

struct Unit { int pm, pn, seg = 0; };
struct Gemm { const bf16_t* A; const bf16_t* Bt; int M, N, K, lda, ldb; size_t segA = 0, segB = 0; };

struct StaticOrder {
    int nM, nN, nwg, G, c;
    __host__ __device__ void init(int M, int N, int G_, int c_) { nM = M / BM; nN = N / BM; nwg = nM * nN; G = G_; c = c_; }
    __host__ __device__ bool next(int i, Unit& u) const {
        const long L = (long)i * G + c; if (L >= nwg) return false;
        int wgid = (int)L; { const int q = nwg / NXCD, r = nwg % NXCD, xcd = wgid % NXCD, off = wgid / NXCD; wgid = (xcd < r ? xcd * (q + 1) : r * (q + 1) + (xcd - r) * q) + off; }
        const int nig = WGM * nN, gid = wgid / nig, fm = gid * WGM, gsz = (nM - fm) < WGM ? (nM - fm) : WGM;
        u.pm = fm + ((wgid % nig) % gsz); u.pn = (wgid % nig) / gsz; return true;
    }
    __device__ __forceinline__ void a_ready(const Unit&) const {}
    __device__ __forceinline__ void done(const Unit&) const {}
};

typedef float f32x2_cv __attribute__((ext_vector_type(2))); typedef __bf16 bf16x2_cv __attribute__((ext_vector_type(2)));
__device__ __forceinline__ unsigned cvt_pk_bf16(float lo, float hi) { const f32x2_cv v = {lo, hi}; const bf16x2_cv b = __builtin_convertvector(v, bf16x2_cv); return __builtin_bit_cast(unsigned, b); }
typedef float f32x2 __attribute__((ext_vector_type(2)));
struct SegOrder {
    StaticOrder base;
    __host__ __device__ bool next(int i, Unit& u) const { if (!base.next(i / 3, u)) return false; u.seg = i - 3 * (i / 3); return true; }
    __device__ __forceinline__ void a_ready(const Unit&) const {}
    __device__ __forceinline__ void done(const Unit&) const {}
};
typedef unsigned short u16_t;
__device__ __forceinline__ float sigmoid_f(float x) { return __builtin_amdgcn_rcpf(1.0f + __builtin_amdgcn_exp2f(-1.4426950408889634f * x)); }
__device__ __forceinline__ void unpack8(const u32x4 w, float (&f)[8]) {
#pragma unroll
    for (int i = 0; i < 4; ++i) { f[2 * i] = __uint_as_float(w[i] << 16); f[2 * i + 1] = __uint_as_float(w[i] & 0xffff0000u); }
}
__device__ __forceinline__ u32x4 pack8(const float (&f)[8]) { u32x4 w; w.x = cvt_pk_bf16(f[0], f[1]); w.y = cvt_pk_bf16(f[2], f[3]); w.z = cvt_pk_bf16(f[4], f[5]); w.w = cvt_pk_bf16(f[6], f[7]); return w; }

__device__ __forceinline__ float rstd_of(float ss) { return __builtin_amdgcn_rsqf(ss * (1.0f / 1024.0f) + 1e-6f); }
__device__ __forceinline__ float sum16(const float* p) { const f32x4 a = *(const f32x4*)p, b = *(const f32x4*)(p + 4), c = *(const f32x4*)(p + 8), d = *(const f32x4*)(p + 12);
    return (((a[0] + a[1]) + (a[2] + a[3])) + ((b[0] + b[1]) + (b[2] + b[3]))) + (((c[0] + c[1]) + (c[2] + c[3])) + ((d[0] + d[1]) + (d[2] + d[3]))); }
template <int ACT, int SCALE  > struct EpiAct {
    static constexpr bool PERM = true, AFTER_DRAIN = false, SEG = false;
    bf16_t* O; int ldc; const float* ss;
    const float* qg = nullptr; const float* kg = nullptr; float qscale = 1.f;
    __device__ __forceinline__ void operator()(const f32x4 (&acc)[2][2][4][2], const Unit& u, int wr, int wc, int fr, int fq) const {
        const int row0 = u.pm * BM + wr * 64 + fr, col0 = u.pn * BM + wc * 32 + 8 * fq;
        if (qg != nullptr && u.pn >= 8 && u.pn < 12) {
            const int lane = fq * 16 + fr; const bool isq = u.pn < 10; const float* gp = (isq ? qg : kg) + 8 * fq; const float gsc = isq ? qscale : 1.f;
            float g[2][8];
#pragma unroll
            for (int bj = 0; bj < 2; ++bj) { const f32x4 g0 = *(const f32x4*)(gp + 32 * bj), g1 = *(const f32x4*)(gp + 32 * bj + 4);
                g[bj][0] = g0[0] * gsc; g[bj][1] = g0[1] * gsc; g[bj][2] = g0[2] * gsc; g[bj][3] = g0[3] * gsc; g[bj][4] = g1[0] * gsc; g[bj][5] = g1[1] * gsc; g[bj][6] = g1[2] * gsc; g[bj][7] = g1[3] * gsc; }
#pragma unroll
            for (int ai = 0; ai < 2; ++ai)
#pragma unroll
                for (int m = 0; m < 4; ++m) { const int row = row0 + ai * HALF + m * 16; bf16_t* rowp = O + (size_t)row * ldc + u.pn * BM + wc * 64 + 8 * fq;
                    const float rs = SCALE == 1 ? rstd_of(ss[row]) : SCALE == 2 ? rstd_of(sum16(ss + (size_t)row * 16)) : 1.f;
                    float f[2][8]; float sq = 0.f;
#pragma unroll
                    for (int bj = 0; bj < 2; ++bj) { const f32x4 v0 = acc[ai][bj][m][0], v1 = acc[ai][bj][m][1];
                        f[bj][0] = v0[0] * rs; f[bj][1] = v0[1] * rs; f[bj][2] = v0[2] * rs; f[bj][3] = v0[3] * rs; f[bj][4] = v1[0] * rs; f[bj][5] = v1[1] * rs; f[bj][6] = v1[2] * rs; f[bj][7] = v1[3] * rs;
#pragma unroll
                        for (int j = 0; j < 8; ++j) sq += f[bj][j] * f[bj][j]; }
                    sq += __int_as_float(__builtin_amdgcn_ds_bpermute((lane ^ 16) << 2, __float_as_int(sq)));
                    sq += __int_as_float(__builtin_amdgcn_ds_bpermute((lane ^ 32) << 2, __float_as_int(sq)));
                    const float rq = __builtin_amdgcn_rsqf(sq * (1.0f / 64.0f) + 1e-6f);
#pragma unroll
                    for (int bj = 0; bj < 2; ++bj) {
#pragma unroll
                        for (int j = 0; j < 8; ++j) f[bj][j] = f[bj][j] * rq * g[bj][j];
                        *(u32x4*)(rowp + 32 * bj) = pack8(f[bj]); }
                    asm volatile("" ::: "memory"); }
            return;
        }
#pragma unroll
        for (int ai = 0; ai < 2; ++ai)
#pragma unroll
            for (int m = 0; m < 4; ++m) { const int row = row0 + ai * HALF + m * 16; bf16_t* rowp = O + (size_t)row * ldc + col0;
                const float rs = SCALE == 1 ? rstd_of(ss[row]) : SCALE == 2 ? rstd_of(sum16(ss + (size_t)row * 16)) : 1.f;
#pragma unroll
                for (int bj = 0; bj < 2; ++bj) { const f32x4 v0 = acc[ai][bj][m][0], v1 = acc[ai][bj][m][1];
                    float f[8] = {v0[0], v0[1], v0[2], v0[3], v1[0], v1[1], v1[2], v1[3]};
#pragma unroll
                    for (int j = 0; j < 8; ++j) { if (SCALE) f[j] *= rs; if (ACT == 1) f[j] = sigmoid_f(f[j]); if (ACT == 2) { const float r = fmaxf(f[j], 0.f); f[j] = r * r; } }
                    *(u32x4*)(rowp + bj * HALF) = pack8(f); }
                asm volatile("" ::: "memory"); }
    }
};
template <bool FIRST> struct EpiMerge {
    static constexpr bool PERM = true, AFTER_DRAIN = false, SEG = false;
    const bf16_t* G; int ldg; bf16_t* Mg;
    __device__ __forceinline__ void operator()(const f32x4 (&acc)[2][2][4][2], const Unit& u, int wr, int wc, int fr, int fq) const {
        const int row0 = u.pm * BM + wr * 64 + fr, col0 = u.pn * BM + wc * 32 + 8 * fq;
#pragma unroll
        for (int ai = 0; ai < 2; ++ai)
#pragma unroll
            for (int m = 0; m < 4; ++m) { const size_t row = (size_t)(row0 + ai * HALF + m * 16);
#pragma unroll
                for (int bj = 0; bj < 2; ++bj) { const f32x4 v0 = acc[ai][bj][m][0], v1 = acc[ai][bj][m][1];
                    const float a[8] = {v0[0], v0[1], v0[2], v0[3], v1[0], v1[1], v1[2], v1[3]};
                    float g[8], o[8]; unpack8(*(const u32x4*)(G + row * ldg + col0 + bj * HALF), g);
                    bf16_t* mp = Mg + row * 1024 + col0 + bj * HALF;
                    if (FIRST) {
#pragma unroll
                        for (int j = 0; j < 8; ++j) o[j] = g[j] * a[j];
                    } else { unpack8(*(const u32x4*)mp, o);
#pragma unroll
                        for (int j = 0; j < 8; ++j) o[j] += g[j] * a[j]; }
                    *(u32x4*)mp = pack8(o); asm volatile("" ::: "memory"); } }
    }
};
struct EpiMergeR {
    static constexpr bool PERM = true, AFTER_DRAIN = false, SEG = true;
    const bf16_t* G; bf16_t* Mg;
    __device__ __forceinline__ void seg(f32x4 (&acc)[2][2][4][2], const Unit& u, int wr, int wc, int fr, int fq) const {
        const int row0 = u.pm * BM + wr * 64 + fr, col0 = u.pn * BM + wc * 32 + 8 * fq;
        const bool last = (u.seg == 2);
        const bf16_t* pn = G + u.seg * 1024 + (size_t)row0 * 3072 + col0;
        const int doff = last ? 0 : 1024;
        asm volatile("s_nop 15\n\ts_nop 7" ::: "memory");
#pragma unroll
        for (int ai = 0; ai < 2; ++ai)
#pragma unroll
            for (int m = 0; m < 4; ++m) {
                asm volatile("" : "+v"(pn));
#pragma unroll
                for (int bj = 0; bj < 2; ++bj) {
                    float gn[8], gd[8]; unpack8(*(const u32x4*)(pn + bj * HALF), gn); unpack8(*(const u32x4*)(pn + doff + bj * HALF), gd);
#pragma unroll
                    for (int j = 0; j < 8; ++j) { const float den = last ? 1.f : __builtin_amdgcn_rcpf(fmaxf(gd[j], 1e-20f)); float r = fmaxf(gn[j], 1e-20f) * den;
                        asm volatile("" : "+v"(r));
                        float f = acc[ai][bj][m][j >> 2][j & 3]; asm volatile("v_mul_f32 %0, %0, %1" : "+v"(f) : "v"(r)); acc[ai][bj][m][j >> 2][j & 3] = f; } }
                pn += (m == 3 ? (HALF - 48) : 16) * 3072;
                asm volatile("" ::: "memory"); }
        if (last) {
            bf16_t* po = Mg + (size_t)row0 * 1024 + col0;
#pragma unroll
            for (int ai = 0; ai < 2; ++ai)
#pragma unroll
                for (int m = 0; m < 4; ++m) {
                    asm volatile("" : "+v"(po));
#pragma unroll
                    for (int bj = 0; bj < 2; ++bj) { const f32x4 v0 = acc[ai][bj][m][0], v1 = acc[ai][bj][m][1];
                        const float f[8] = {v0[0], v0[1], v0[2], v0[3], v1[0], v1[1], v1[2], v1[3]};
                        *(u32x4*)(po + bj * HALF) = pack8(f); }
                    po += (m == 3 ? (HALF - 48) : 16) * 1024;
                    asm volatile("" ::: "memory"); }
        }
    }
};
struct EpiResid {
    static constexpr bool PERM = true, AFTER_DRAIN = false, SEG = false;
    const float* base; float* out;
    __device__ __forceinline__ void operator()(const f32x4 (&acc)[2][2][4][2], const Unit& u, int wr, int wc, int fr, int fq) const {
        const int row0 = u.pm * BM + wr * 64 + fr, col0 = u.pn * BM + wc * 32 + 8 * fq;
#pragma unroll
        for (int ai = 0; ai < 2; ++ai)
#pragma unroll
            for (int m = 0; m < 4; ++m) { const size_t off = (size_t)(row0 + ai * HALF + m * 16) * 1024 + col0;
#pragma unroll
                for (int bj = 0; bj < 2; ++bj) { const f32x4 b0 = *(const f32x4*)(base + off + bj * HALF), b1 = *(const f32x4*)(base + off + bj * HALF + 4);
                    *(f32x4*)(out + off + bj * HALF) = b0 + acc[ai][bj][m][0]; *(f32x4*)(out + off + bj * HALF + 4) = b1 + acc[ai][bj][m][1]; }
                if (m & 1) asm volatile("" ::: "memory"); }
    }
};
struct EpiResidN {
    static constexpr bool PERM = true, AFTER_DRAIN = false, SEG = false;
    const float* basef; bf16_t* hb; float* ss;
    __device__ __forceinline__ void operator()(const f32x4 (&acc)[2][2][4][2], const Unit& u, int wr, int wc, int fr, int fq) const {
        const int row0 = u.pm * BM + wr * 64 + fr, col0 = u.pn * BM + wc * 32 + 8 * fq, lane = fq * 16 + fr;
#pragma unroll
        for (int ai = 0; ai < 2; ++ai)
#pragma unroll
            for (int m = 0; m < 4; ++m) { const int row = row0 + ai * HALF + m * 16; const size_t off = (size_t)row * 1024 + col0; float sq = 0.f;
#pragma unroll
                for (int bj = 0; bj < 2; ++bj) { float b[8];
                    if (basef) { const f32x4 b0 = *(const f32x4*)(basef + off + bj * HALF), b1 = *(const f32x4*)(basef + off + bj * HALF + 4);
                        b[0] = b0[0]; b[1] = b0[1]; b[2] = b0[2]; b[3] = b0[3]; b[4] = b1[0]; b[5] = b1[1]; b[6] = b1[2]; b[7] = b1[3]; }
                    else unpack8(*(const u32x4*)(hb + off + bj * HALF), b);
                    const f32x4 a0 = acc[ai][bj][m][0], a1 = acc[ai][bj][m][1];
                    const float f[8] = {b[0] + a0[0], b[1] + a0[1], b[2] + a0[2], b[3] + a0[3], b[4] + a1[0], b[5] + a1[1], b[6] + a1[2], b[7] + a1[3]};
#pragma unroll
                    for (int j = 0; j < 8; ++j) sq += f[j] * f[j];
                    *(u32x4*)(hb + off + bj * HALF) = pack8(f); }
                sq += __int_as_float(__builtin_amdgcn_ds_bpermute((lane ^ 16) << 2, __float_as_int(sq)));
                sq += __int_as_float(__builtin_amdgcn_ds_bpermute((lane ^ 32) << 2, __float_as_int(sq)));
                if (fq == 0) ss[(size_t)row * 16 + u.pn * 4 + wc] = sq;
                if (m & 1) asm volatile("" ::: "memory"); }
    }
};
struct EpiPle {
    static constexpr bool PERM = true, AFTER_DRAIN = false, SEG = false;
    const bf16_t* baseb; float* out; bf16_t* PP; const float* ss; float* ssout;
    __device__ __forceinline__ void operator()(const f32x4 (&acc)[2][2][4][2], const Unit& u, int wr, int wc, int fr, int fq) const {
        const int row0 = u.pm * BM + wr * 64 + fr, col0 = u.pn * BM + wc * 32 + 8 * fq, lane = fq * 16 + fr;
#pragma unroll
        for (int ai = 0; ai < 2; ++ai)
#pragma unroll
            for (int m = 0; m < 4; ++m) { const int row = row0 + ai * HALF + m * 16; const size_t off = (size_t)row * 1024 + col0; const float rs = rstd_of(sum16(ss + (size_t)row * 16)); float sq = 0.f;
#pragma unroll
                for (int bj = 0; bj < 2; ++bj) { float bb[8], pp[8]; unpack8(*(const u32x4*)(baseb + off + bj * HALF), bb); unpack8(*(const u32x4*)(PP + off + bj * HALF), pp);
                    const f32x4 v0 = acc[ai][bj][m][0], v1 = acc[ai][bj][m][1];
                    float f[8];
#pragma unroll
                    for (int j = 0; j < 4; ++j) { f[j] = bb[j] + sigmoid_f(v0[j] * rs) * pp[j]; f[4 + j] = bb[4 + j] + sigmoid_f(v1[j] * rs) * pp[4 + j]; }
                    if (out) { *(f32x4*)(out + off + bj * HALF) = (f32x4){f[0], f[1], f[2], f[3]}; *(f32x4*)(out + off + bj * HALF + 4) = (f32x4){f[4], f[5], f[6], f[7]}; }
                    else {
#pragma unroll
                        for (int j = 0; j < 8; ++j) sq += f[j] * f[j];
                        *(u32x4*)(PP + off + bj * HALF) = pack8(f); } }
                if (!out) { sq += __int_as_float(__builtin_amdgcn_ds_bpermute((lane ^ 16) << 2, __float_as_int(sq)));
                            sq += __int_as_float(__builtin_amdgcn_ds_bpermute((lane ^ 32) << 2, __float_as_int(sq)));
                            if (fq == 0) ssout[(size_t)row * 16 + u.pn * 4 + wc] = sq; }
                if (m & 1) asm volatile("" ::: "memory"); }
    }
};

template <class Epi, class Sched, bool ALIGN_EPI = false, bool SP2 = false>
__device__ __forceinline__ void gemm_phase(PG8_LAS unsigned char* lds, const Gemm g, const Sched& S, const Epi& E, const int tid_in) {
    int tid = tid_in; asm volatile("" : "+v"(tid));
    const int wid = __builtin_amdgcn_readfirstlane(tid >> 6), lane = tid & 63, wr = wid >> 2, wc = wid & 3, fr = lane & 15, fq = lane >> 4;
    int Kq = g.K; asm volatile("" : "+s"(Kq)); const int nt = Kq / BK;
    unsigned voffA[2], voffB[2];
#pragma unroll
    for (int i = 0; i < 2; ++i) { int R, C; stage_rc(tid * 16 + i * 8192, R, C); const int Rb = Epi::PERM ? ((R & ~31) + perm32(R & 31)) : R;
        voffA[i] = (unsigned)(R * g.lda + C) * 2u; voffB[i] = (unsigned)(Rb * g.ldb + C) * 2u; }
    const size_t kstep = (size_t)(BK * 2);
    const size_t hstepA = (size_t)HALF * g.lda * 2, hstepB = (size_t)HALF * g.ldb * 2;
    const size_t tstepA = 2 * hstepA, tstepB = 2 * hstepB;
    const unsigned ldsw = (unsigned)wid * 1024u;
    const int aoff = lds_byte(wr * 64 + fr, fq * 8), boff = lds_byte(wc * 32 + fr, fq * 8);
#define PG8_SA(b, h) (((b) * 2 + (h)) * HTB)
#define PG8_SB(b, h) ((4 + (b) * 2 + (h)) * HTB)
#define PG8_STAGE(bufoff, gbase, voff) do { _Pragma("unroll") for (int _i = 0; _i < 2; ++_i) \
        __builtin_amdgcn_global_load_lds((const unsigned*)((const char*)(gbase) + (voff)[_i]), (PG8_LAS unsigned*)(lds + (bufoff) + ldsw + _i * 8192), 16, 0, 0); } while (0)
#define PG8_LDA(dst, b, h) do { _Pragma("unroll") for (int m = 0; m < 4; ++m) _Pragma("unroll") for (int k = 0; k < 2; ++k) dst[m][k] = *(const PG8_LAS bf16x8*)(lds + PG8_SA(b, h) + aoff + m * 2048 + k * 1024); } while (0)
#define PG8_LDB(dst, b, h) do { _Pragma("unroll") for (int n = 0; n < 2; ++n) _Pragma("unroll") for (int k = 0; k < 2; ++k) dst[n][k] = *(const PG8_LAS bf16x8*)(lds + PG8_SB(b, h) + boff + n * 2048 + k * 1024); } while (0)
#define PG8_MMA(ai, bj, At, Bt) do { __builtin_amdgcn_s_setprio(1); _Pragma("unroll") for (int m = 0; m < 4; ++m) _Pragma("unroll") for (int n = 0; n < 2; ++n) _Pragma("unroll") for (int k = 0; k < 2; ++k) \
        acc[ai][bj][m][n] = __builtin_amdgcn_mfma_f32_16x16x32_bf16(Bt[n][k], At[m][k], acc[ai][bj][m][n], 0, 0, 0); __builtin_amdgcn_s_setprio(0); } while (0)
#define PG8_WAIT_V(n) asm volatile("s_waitcnt vmcnt(" #n ")" ::: "memory")
#define PG8_WAIT_L(n) asm volatile("s_waitcnt lgkmcnt(" #n ")" ::: "memory")
#define PG8_BAR __builtin_amdgcn_s_barrier()
#define PG8_SCHED __builtin_amdgcn_sched_barrier(0)
    Unit cur, nxt; int ui = 0;
    if (!S.next(0, cur)) return;
    f32x4 acc[2][2][4][2];
#pragma unroll
    for (int a = 0; a < 2; ++a)
#pragma unroll
        for (int b = 0; b < 2; ++b)
#pragma unroll
            for (int m = 0; m < 4; ++m)
#pragma unroll
                for (int n = 0; n < 2; ++n) acc[a][b][m][n] = (f32x4){0.f, 0.f, 0.f, 0.f};
    bf16x8 At[4][2], B0[2][2], B1[2][2];
    const char* cA = (const char*)g.A + (size_t)cur.pm * tstepA + (size_t)cur.seg * g.segA; const char* cB = (const char*)g.Bt + (size_t)cur.pn * tstepB + (size_t)cur.seg * g.segB;
    S.a_ready(cur);
    if constexpr (SP2) {
        PG8_STAGE(PG8_SB(0, 0), cB, voffB); PG8_STAGE(PG8_SB(0, 1), cB + hstepB, voffB); PG8_STAGE(PG8_SA(0, 0), cA, voffA); PG8_STAGE(PG8_SA(0, 1), cA + hstepA, voffA);
        if (wr == 1) PG8_BAR;
        PG8_WAIT_V(2); PG8_BAR;
        PG8_STAGE(PG8_SB(1, 0), cB + kstep, voffB); PG8_STAGE(PG8_SA(1, 0), cA + kstep, voffA); PG8_STAGE(PG8_SB(1, 1), cB + hstepB + kstep, voffB);
        PG8_WAIT_V(6); PG8_BAR;
    } else {
        PG8_STAGE(PG8_SB(0, 0), cB, voffB); PG8_STAGE(PG8_SA(0, 0), cA, voffA); PG8_STAGE(PG8_SB(0, 1), cB + hstepB, voffB); PG8_STAGE(PG8_SA(0, 1), cA + hstepA, voffA);
        if (wr == 1) PG8_BAR;
        PG8_WAIT_V(4); PG8_BAR;
        PG8_STAGE(PG8_SB(1, 0), cB + kstep, voffB); PG8_STAGE(PG8_SA(1, 0), cA + kstep, voffA); PG8_STAGE(PG8_SB(1, 1), cB + hstepB + kstep, voffB);
        PG8_WAIT_V(6); PG8_BAR;
    }
    for (;;) {
        const bool has_next = S.next(ui + 1, nxt);
        const char* nA = has_next ? (const char*)g.A + (size_t)nxt.pm * tstepA + (size_t)nxt.seg * g.segA : cA; const char* nB = has_next ? (const char*)g.Bt + (size_t)nxt.pn * tstepB + (size_t)nxt.seg * g.segB : cB;
        for (int t = 0; t < nt; t += 2) {
            const bool last = (t == nt - 2);
            const char* a1 = cA + (size_t)(t + 1) * kstep;
            const char* a2 = last ? nA : cA + (size_t)(t + 2) * kstep; const char* b2 = last ? nB : cB + (size_t)(t + 2) * kstep;
            const char* a3 = a2 + kstep; const char* b3 = b2 + kstep;
            if (last && has_next) S.a_ready(nxt);
            if constexpr (SP2) {
            PG8_LDB(B0, 0, 0); PG8_LDB(B1, 0, 1); PG8_SCHED; PG8_LDA(At, 0, 0); PG8_STAGE(PG8_SA(1, 1), a1 + hstepA, voffA);
            PG8_WAIT_V(8); PG8_WAIT_L(0); PG8_BAR; PG8_MMA(0, 0, At, B0); PG8_MMA(0, 1, At, B1); PG8_BAR; PG8_SCHED;
            PG8_LDA(At, 0, 1); PG8_STAGE(PG8_SB(0, 0), b2, voffB); PG8_STAGE(PG8_SB(0, 1), b2 + hstepB, voffB); PG8_STAGE(PG8_SA(0, 0), a2, voffA);
            PG8_WAIT_V(8); PG8_WAIT_L(0); PG8_BAR; PG8_MMA(1, 0, At, B0); PG8_MMA(1, 1, At, B1); PG8_BAR; PG8_SCHED;
            PG8_LDB(B0, 1, 0); PG8_LDB(B1, 1, 1); PG8_SCHED; PG8_LDA(At, 1, 0); PG8_STAGE(PG8_SA(0, 1), a2 + hstepA, voffA);
            PG8_WAIT_V(8); PG8_WAIT_L(0); PG8_BAR; PG8_MMA(0, 0, At, B0); PG8_MMA(0, 1, At, B1); PG8_BAR; PG8_SCHED;
            PG8_LDA(At, 1, 1); PG8_STAGE(PG8_SB(1, 0), b3, voffB); PG8_STAGE(PG8_SB(1, 1), b3 + hstepB, voffB); PG8_STAGE(PG8_SA(1, 0), a3, voffA);
            PG8_WAIT_V(8); PG8_WAIT_L(0); PG8_BAR; PG8_MMA(1, 0, At, B0); PG8_MMA(1, 1, At, B1); PG8_BAR; PG8_SCHED;
            } else {
            PG8_LDB(B0, 0, 0); PG8_SCHED; PG8_LDA(At, 0, 0); PG8_STAGE(PG8_SA(1, 1), a1 + hstepA, voffA);
            PG8_WAIT_L(8); PG8_BAR; PG8_WAIT_L(0); PG8_MMA(0, 0, At, B0); PG8_BAR; PG8_SCHED;
            PG8_LDB(B1, 0, 1); PG8_STAGE(PG8_SB(0, 0), b2, voffB);
            PG8_BAR; PG8_WAIT_L(0); PG8_MMA(0, 1, At, B1); PG8_BAR;
            PG8_LDA(At, 0, 1); PG8_STAGE(PG8_SA(0, 0), a2, voffA);
            PG8_BAR; PG8_WAIT_L(0); PG8_MMA(1, 0, At, B0); PG8_BAR; PG8_SCHED;
            PG8_STAGE(PG8_SB(0, 1), b2 + hstepB, voffB);
            PG8_WAIT_V(6); PG8_BAR; PG8_MMA(1, 1, At, B1); PG8_BAR;
            PG8_LDB(B0, 1, 0); PG8_SCHED; PG8_LDA(At, 1, 0); PG8_STAGE(PG8_SA(0, 1), a2 + hstepA, voffA);
            PG8_WAIT_L(8); PG8_BAR; PG8_WAIT_L(0); PG8_MMA(0, 0, At, B0); PG8_BAR; PG8_SCHED;
            PG8_LDB(B1, 1, 1); PG8_STAGE(PG8_SB(1, 0), b3, voffB);
            PG8_BAR; PG8_WAIT_L(0); PG8_MMA(0, 1, At, B1); PG8_BAR;
            PG8_LDA(At, 1, 1); PG8_STAGE(PG8_SA(1, 0), a3, voffA);
            PG8_BAR; PG8_WAIT_L(0); PG8_MMA(1, 0, At, B0); PG8_BAR; PG8_SCHED;
            PG8_STAGE(PG8_SB(1, 1), b3 + hstepB, voffB);
            PG8_WAIT_V(6); PG8_BAR; PG8_MMA(1, 1, At, B1); PG8_BAR;
            }
        }
        if constexpr (ALIGN_EPI) { if (wr == 0) PG8_BAR; }
        if constexpr (Epi::SEG) { E.seg(acc, cur, wr, wc, fr, fq); } else if constexpr (!Epi::AFTER_DRAIN) { E(acc, cur, wr, wc, fr, fq); S.done(cur); }
        if (!has_next) break;
        if constexpr (Epi::SEG) {
            const float keep = (cur.seg != 2) ? 1.f : 0.f;
#pragma unroll
            for (int a = 0; a < 2; ++a)
#pragma unroll
                for (int b = 0; b < 2; ++b)
#pragma unroll
                    for (int m = 0; m < 4; ++m)
#pragma unroll
                        for (int n = 0; n < 2; ++n)
#pragma unroll
                            for (int j = 0; j < 4; ++j) { float f = acc[a][b][m][n][j]; asm volatile("v_mul_f32 %0, %0, %1" : "+v"(f) : "s"(keep)); acc[a][b][m][n][j] = f; }
        } else {
#pragma unroll
            for (int a = 0; a < 2; ++a)
#pragma unroll
                for (int b = 0; b < 2; ++b)
#pragma unroll
                    for (int m = 0; m < 4; ++m)
#pragma unroll
                        for (int n = 0; n < 2; ++n) acc[a][b][m][n] = (f32x4){0.f, 0.f, 0.f, 0.f};
        }
        cur = nxt; cA = nA; cB = nB; ++ui;
        if constexpr (ALIGN_EPI) { if (wr == 1) PG8_BAR; }
    }
    PG8_WAIT_V(0);
    if constexpr (!ALIGN_EPI) { if (wr == 0) PG8_BAR; }
    PG8_BAR;
    if constexpr (Epi::AFTER_DRAIN) { E.fused(acc, cur, wr, wc, fr, fq, lds, wid, lane); S.done(cur); }
#undef PG8_SA
#undef PG8_SB
#undef PG8_STAGE
#undef PG8_LDA
#undef PG8_LDB
#undef PG8_MMA
#undef PG8_WAIT_V
#undef PG8_WAIT_L
#undef PG8_BAR
#undef PG8_SCHED
}
}

#include <hip/hip_bf16.h>
#include <cmath>
namespace attn_body {
using bf16=__hip_bfloat16;
using bf16x8=__attribute__((ext_vector_type(8)))short;
using s16x4=__attribute__((ext_vector_type(4)))short;
using f32x16=__attribute__((ext_vector_type(16)))float;
using u32x4=__attribute__((ext_vector_type(4)))unsigned;
constexpr int BATCH=4,NVH=16,SEQ=8192,D=64,PQ=3584,PO=1024,PY=1536;
constexpr int NW=8,QBLK=32,QB=QBLK*NW,KVBLK=64,NQB=SEQ/QB;
constexpr int ATTN_UNIT_ROWS=QB;
__device__ __forceinline__ int crow(int r,int hi){return (r&3)+8*(r>>2)+4*hi;}
#define SBAR() __builtin_amdgcn_sched_barrier(0)
__device__ __forceinline__ void cmask(f32x16&p0,f32x16&p1,int jb,int wid){
  const float NEG=-INFINITY;
  if(jb>(wid>>1)){
  #pragma unroll
  for(int r=0;r<16;++r){p0[r]=NEG;p1[r]=NEG;}}
}

constexpr int NSLOT=3, SLOTB=8192, VSLOTB=2*SLOTB;
constexpr int LDS_K=0, LDS_V=NSLOT*SLOTB, LDS_WS=LDS_V+NSLOT*VSLOTB, LDS_OST=LDS_WS+NW*64*4, LDS_BYTES=LDS_OST+NW*4096;
constexpr float C2=0.125f*1.4426950408889634f;
__device__ __forceinline__ void glds16(const void*gsrc,unsigned lds_dst){unsigned keep;
  asm volatile("s_mov_b32 %0, m0\n\ts_mov_b32 m0, %2\n\ts_nop 0\n\tglobal_load_lds_dwordx4 %1, off\n\ts_mov_b32 m0, %0":"=&s"(keep):"v"(gsrc),"s"(lds_dst):"memory");}
__device__ __forceinline__ float max3f(float a,float b,float c){float r;asm("v_max3_f32 %0, %1, %2, %3":"=v"(r):"v"(a),"v"(b),"v"(c));return r;}
__device__ __forceinline__ float max2f(float a,float b){float r;asm("v_max_f32_e32 %0, %1, %2":"=v"(r):"v"(a),"v"(b));return r;}
__device__ __forceinline__ float fadd_s(float a,float b){float r;asm("v_add_f32_e32 %0, %1, %2":"=v"(r):"v"(a),"v"(b));return r;}
__device__ __forceinline__ float fsub_s(float a,float b){float r;asm("v_sub_f32_e32 %0, %1, %2":"=v"(r):"v"(a),"v"(b));return r;}
typedef float f32x2_t __attribute__((ext_vector_type(2))); typedef __bf16 bf16x2_t __attribute__((ext_vector_type(2)));
__device__ __forceinline__ unsigned cvtpk_s(float lo,float hi){f32x2_t v={lo,hi};bf16x2_t b=__builtin_convertvector(v,bf16x2_t);return __builtin_bit_cast(unsigned,b);}
#define WAIT_BAR(N) asm volatile("s_waitcnt vmcnt(" #N ") lgkmcnt(0)\n\ts_barrier":::"memory")

__device__ __forceinline__ void qkt(f32x16&p0,f32x16&p1,const char*Kslot,const bf16x8*qr,const f32x16&negm,int r32,int hi){
  const char*kb=Kslot+hi*1024+r32*16;
  #pragma unroll
  for(int d0=0;d0<4;++d0){
    const bf16x8 b0=*reinterpret_cast<const bf16x8*>(kb+d0*2048);
    const bf16x8 b1=*reinterpret_cast<const bf16x8*>(kb+d0*2048+512);
    if(d0==0){p0=__builtin_amdgcn_mfma_f32_32x32x16_bf16(b0,qr[0],negm,0,0,0);p1=__builtin_amdgcn_mfma_f32_32x32x16_bf16(b1,qr[0],negm,0,0,0);}
    else{p0=__builtin_amdgcn_mfma_f32_32x32x16_bf16(b0,qr[d0],p0,0,0,0);p1=__builtin_amdgcn_mfma_f32_32x32x16_bf16(b1,qr[d0],p1,0,0,0);}}
}
typedef __attribute__((address_space(3))) const char* lds_cptr;
typedef short v4i16_t __attribute__((ext_vector_type(4)));
__device__ __forceinline__ void kload8(bf16x8*kf,lds_cptr kp){
  kf[0]=*(const __attribute__((address_space(3))) bf16x8*)(kp);      kf[1]=*(const __attribute__((address_space(3))) bf16x8*)(kp+512);
  kf[2]=*(const __attribute__((address_space(3))) bf16x8*)(kp+2048); kf[3]=*(const __attribute__((address_space(3))) bf16x8*)(kp+2560);
  kf[4]=*(const __attribute__((address_space(3))) bf16x8*)(kp+4096); kf[5]=*(const __attribute__((address_space(3))) bf16x8*)(kp+4608);
  kf[6]=*(const __attribute__((address_space(3))) bf16x8*)(kp+6144); kf[7]=*(const __attribute__((address_space(3))) bf16x8*)(kp+6656);
}
__device__ __forceinline__ void kload2(bf16x8*kf,lds_cptr kp,int j){ kf[2*j]=*(const __attribute__((address_space(3))) bf16x8*)(kp+j*2048); kf[2*j+1]=*(const __attribute__((address_space(3))) bf16x8*)(kp+j*2048+512); }
__device__ __forceinline__ s16x4 vtr(lds_cptr p){ return __builtin_bit_cast(s16x4,__builtin_amdgcn_ds_read_tr16_b64_v4i16((__attribute__((address_space(3))) v4i16_t*)p)); }
__device__ __forceinline__ float rowmax(const f32x16&p0,const f32x16&p1){
  float a=max3f(p0[0],p0[1],p1[0]),b=max3f(p0[2],p0[3],p1[1]);a=max3f(a,p1[2],p1[3]);
  #pragma unroll
  for(int r=4;r<16;r+=4){a=max3f(a,p0[r],p0[r+1]);b=max3f(b,p0[r+2],p0[r+3]);a=max3f(a,p1[r],p1[r+1]);b=max3f(b,p1[r+2],p1[r+3]);}
  const float m=max2f(a,b);
  auto rr=__builtin_amdgcn_permlane32_swap(__float_as_uint(m),__float_as_uint(m),false,false);
  return max2f(__uint_as_float(rr[0]),__uint_as_float(rr[1]));
}
__device__ __forceinline__ void pv(f32x16*o,int vb,bf16x8 pa0,bf16x8 pa1,bf16x8 pa2,bf16x8 pa3){
  #pragma unroll
  for(int d0=0;d0<4;++d0){s16x4 lo[4],hi[4];
    #pragma unroll
    for(int ks=0;ks<4;++ks){
      asm volatile("ds_read_b64_tr_b16 %0,%1 offset:%c2":"=&v"(lo[ks]):"v"(vb),"i"(d0*4096+ks*1024):"memory");
      asm volatile("ds_read_b64_tr_b16 %0,%1 offset:%c2":"=&v"(hi[ks]):"v"(vb),"i"(d0*4096+ks*1024+512):"memory");}
    asm volatile("s_waitcnt lgkmcnt(0)":::"memory");SBAR();
    #define PK(k) (bf16x8){lo[k][0],lo[k][1],lo[k][2],lo[k][3],hi[k][0],hi[k][1],hi[k][2],hi[k][3]}
    o[d0]=__builtin_amdgcn_mfma_f32_32x32x16_bf16(pa0,PK(0),o[d0],0,0,0);
    o[d0]=__builtin_amdgcn_mfma_f32_32x32x16_bf16(pa1,PK(1),o[d0],0,0,0);
    o[d0]=__builtin_amdgcn_mfma_f32_32x32x16_bf16(pa2,PK(2),o[d0],0,0,0);
    o[d0]=__builtin_amdgcn_mfma_f32_32x32x16_bf16(pa3,PK(3),o[d0],0,0,0);
    #undef PK
  }
}

#ifndef ATTN_STORE16
#define ATTN_STORE16(p,v) (*(u32x4*)(p)=(v))
#endif
template<int THRL> __device__ __forceinline__ void attn_unit(int b,int qb,const bf16*Q,const bf16*__restrict__ K,const bf16*__restrict__ V,bf16*O,char*shm,const int tid,const int half,const float lam,const float post,const float*subg,bf16*Yc,const bool hasn,const long dK,const long dV,const bool pre){
  const int lane=tid&63,r32=lane&31,hi=lane>>5; const int wid=__builtin_amdgcn_readfirstlane(tid>>6);
  const long rowbase=(long)b*SEQ; const int q0=qb*QB;
  const bf16*Qw=Q+(rowbase+q0+wid*QBLK)*PQ;
  const bf16*Kh=K+rowbase*PQ,*Vh=V+rowbase*PQ;
  const unsigned lds0=(unsigned)(uintptr_t)shm;
  float*wsf=(float*)(shm+LDS_WS)+wid*64;
  const bf16*ksrc=Kh+(long)lane*PQ+wid*8;
  const bf16*vsrc=Vh+(long)(16*(wid&3)+(lane>>2))*PQ+(wid>>2)*32+(lane&3)*8;
  const unsigned kdst=lds0+LDS_K+wid*1024, vdst=lds0+LDS_V+wid*1024;
  #define DMA_K(t,slot) glds16(ksrc+(long)(t)*KVBLK*PQ,(unsigned)__builtin_amdgcn_readfirstlane(kdst+(slot)))
  #define DMA_V(t,slot) do{ glds16(vsrc+(long)(t)*KVBLK*PQ,(unsigned)__builtin_amdgcn_readfirstlane(vdst+2*(slot))); glds16(vsrc+(long)(t)*KVBLK*PQ+64,(unsigned)__builtin_amdgcn_readfirstlane(vdst+2*(slot)+8192)); }while(0)
  const char*Kbase=shm+LDS_K; bf16x8 kf[8];
  const lds_cptr shm3=(lds_cptr)shm; const lds_cptr kp0=shm3+LDS_K+hi*1024+r32*16; const lds_cptr vp0=shm3+LDS_V+((lane>>4)&1)*32+(lane&3)*8+(4*hi+((lane&15)>>2))*64;
  const int NT=(q0+QB)/KVBLK;
  if(!pre){DMA_K(0,0);DMA_V(0,0);DMA_K(1,SLOTB);}
  bf16x8 qr[4];
  #pragma unroll
  for(int d0=0;d0<4;++d0)qr[d0]=*reinterpret_cast<const bf16x8*>(&Qw[(long)r32*PQ+d0*16+hi*8]);
  float l_reg=0.f;f32x16 o[4];o[0]=f32x16{};o[1]=f32x16{};o[2]=f32x16{};o[3]=f32x16{};const f32x16 zero16=f32x16{};
  #define CMASK(P0,P1,t) do{int jb_=(t)-(NT-4); if(jb_>=0)cmask(P0,P1,jb_,wid);}while(0)
  f32x16 pA0,pA1,pB0,pB1;
  int sl_prev=0,sl_cur=0,sl_next=SLOTB;
  #define ROT() do{sl_prev=sl_cur;sl_cur=sl_next;sl_next=(sl_next==(NSLOT-1)*SLOTB)?0:sl_next+SLOTB;}while(0)
  DMA_K(2,2*SLOTB);
  WAIT_BAR(4);
  qkt(pA0,pA1,Kbase,qr,zero16,r32,hi);asm volatile("s_nop 15\n\ts_nop 7":"+v"(pA0),"+v"(pA1));CMASK(pA0,pA1,0);
  _Pragma("unroll") for(int r=0;r<16;++r)pA0[r]=__builtin_amdgcn_exp2f(pA0[r]);
  _Pragma("unroll") for(int r=0;r<16;++r)pA1[r]=__builtin_amdgcn_exp2f(pA1[r]);
  WAIT_BAR(0);
  DMA_K(3,0);DMA_V(1,SLOTB);
  ROT();
  kload8(kf,kp0+sl_cur);
  WAIT_BAR(3);
  s16x4 vlo[8],vhi[8],wlo[8],whi[8]; u32x4 pw0,pw1,pw2,pw3;
  #define PKW(P,B) cvtpk_s(P[B],P[B+1])
  #define PAF(k) __builtin_bit_cast(bf16x8,pw##k)
  #define VFR(i) (bf16x8){vlo[i][0],vlo[i][1],vlo[i][2],vlo[i][3],vhi[i][0],vhi[i][1],vhi[i][2],vhi[i][3]}
  #define WFR(i) (bf16x8){wlo[i][0],wlo[i][1],wlo[i][2],wlo[i][3],whi[i][0],whi[i][1],whi[i][2],whi[i][3]}
  #define PIN(x) asm volatile("":"+v"(x))
  #define GAPA(MF,A0,A1,A2,A3,W0,W1,PW) do{ MF; sacc+=A0; sacc+=A1; sacc+=A2; sacc+=A3; PIN(sacc); W0; W1; PIN(PW); SBAR(); }while(0)
  #define EX(v) __builtin_amdgcn_exp2f(v)
  #define GAPB(MF,X,B) do{ MF; X[B]=EX(X[B]); X[B+1]=EX(X[B+1]); PIN(X); SBAR(); }while(0)
  #define VRD(i) do{ vlo[i]=vtr(vp_+(((i)>>2)*4096+((i)&3)*1024)); vhi[i]=vtr(vp_+(((i)>>2)*4096+((i)&3)*1024+512)); }while(0)
  #define WRD(i) do{ wlo[i]=vtr(vp_+(8192+((i)>>2)*4096+((i)&3)*1024)); whi[i]=vtr(vp_+(8192+((i)>>2)*4096+((i)&3)*1024+512)); SBAR(); }while(0)
  #define KRD(G,j) do{ if(G){ kload2(kf,kp0+sl_next,j); SBAR(); } }while(0)
  #define MF32(a,b,c) __builtin_amdgcn_mfma_f32_32x32x16_bf16(a,b,c,0,0,0)
  #define STEP(C0,C1,P0,P1,t,GK,GV,GL) do{ SBAR(); \
    const lds_cptr vp_=vp0+2*sl_prev; \
    VRD(0); SBAR(); float sacc=(P0[0]+P0[1]); \
    GAPA(C0=MF32(kf[0],qr[0],zero16), P0[2],P0[3],P0[4],P0[5],     pw0[0]=PKW(P0,0), pw0[1]=PKW(P0,2), pw0); \
    VRD(4); SBAR(); GAPA(C1=MF32(kf[1],qr[0],zero16), P0[6],P0[7],P0[8],P0[9],     pw0[2]=PKW(P0,4), pw0[3]=PKW(P0,6), pw0); \
    VRD(1); SBAR(); GAPA(C0=MF32(kf[2],qr[1],C0),   P0[10],P0[11],P0[12],P0[13], pw1[0]=PKW(P0,8), pw1[1]=PKW(P0,10), pw1); \
    VRD(5); SBAR(); GAPA(C1=MF32(kf[3],qr[1],C1),   P0[14],P0[15],P1[0],P1[1],   pw1[2]=PKW(P0,12),pw1[3]=PKW(P0,14), pw1); \
    VRD(2); SBAR(); GAPA(C0=MF32(kf[4],qr[2],C0),   P1[2],P1[3],P1[4],P1[5],     pw2[0]=PKW(P1,0), pw2[1]=PKW(P1,2), pw2); \
    VRD(6); SBAR(); GAPA(C1=MF32(kf[5],qr[2],C1),   P1[6],P1[7],P1[8],P1[9],     pw2[2]=PKW(P1,4), pw2[3]=PKW(P1,6), pw2); \
    VRD(3); SBAR(); GAPA(C0=MF32(kf[6],qr[3],C0),   P1[10],P1[11],P1[12],P1[13], pw3[0]=PKW(P1,8), pw3[1]=PKW(P1,10), pw3); \
    VRD(7); SBAR(); GAPA(C1=MF32(kf[7],qr[3],C1),   P1[14],P1[15],0.f,0.f,       pw3[2]=PKW(P1,12),pw3[3]=PKW(P1,14), pw3); \
    l_reg+=sacc; \
    if(GK){DMA_K((t)+3,sl_cur);} if(GV){DMA_V((t)+1,sl_next);} \
    CMASK(C0,C1,t); \
    SBAR(); \
    GAPB(o[0]=MF32(PAF(0),VFR(0),o[0]), C0,0);  WRD(0); \
    GAPB(o[1]=MF32(PAF(0),VFR(4),o[1]), C0,2);  WRD(4); \
    GAPB(o[0]=MF32(PAF(1),VFR(1),o[0]), C0,4);  WRD(1); \
    GAPB(o[1]=MF32(PAF(1),VFR(5),o[1]), C0,6);  WRD(5); \
    GAPB(o[0]=MF32(PAF(2),VFR(2),o[0]), C0,8);  WRD(2); \
    GAPB(o[1]=MF32(PAF(2),VFR(6),o[1]), C0,10); WRD(6); \
    GAPB(o[0]=MF32(PAF(3),VFR(3),o[0]), C0,12); WRD(3); \
    GAPB(o[1]=MF32(PAF(3),VFR(7),o[1]), C0,14); WRD(7); \
    GAPB(o[2]=MF32(PAF(0),WFR(0),o[2]), C1,0); \
    GAPB(o[3]=MF32(PAF(0),WFR(4),o[3]), C1,2); \
    KRD(GL,0); GAPB(o[2]=MF32(PAF(1),WFR(1),o[2]), C1,4); \
    KRD(GL,1); GAPB(o[3]=MF32(PAF(1),WFR(5),o[3]), C1,6); \
    KRD(GL,2); GAPB(o[2]=MF32(PAF(2),WFR(2),o[2]), C1,8); \
    KRD(GL,3); GAPB(o[3]=MF32(PAF(2),WFR(6),o[3]), C1,10); \
    GAPB(o[2]=MF32(PAF(3),WFR(3),o[2]), C1,12); \
    GAPB(o[3]=MF32(PAF(3),WFR(7),o[3]), C1,14); \
    }while(0)
  int t=1;
  #undef CMASK
  #define CMASK(P0,P1,t) do{}while(0)
  for(;t+5<NT;t+=2){
    STEP(pB0,pB1,pA0,pA1,t,true,true,true);     WAIT_BAR(3); ROT();
    STEP(pA0,pA1,pB0,pB1,t+1,true,true,true);   WAIT_BAR(3); ROT();
  }
  #undef CMASK
  #define CMASK(P0,P1,t) do{int jb_=(t)-(NT-4); if(jb_>=0)cmask(P0,P1,jb_,wid);}while(0)
  #define ENDW(tt) do{ if((tt)+3<NT){WAIT_BAR(3);} else if((tt)+2<NT){WAIT_BAR(2);} else {WAIT_BAR(0);} }while(0)
  for(;t+1<NT;t+=2){
    STEP(pB0,pB1,pA0,pA1,t,(t+3<NT),(t+1<NT),(t+1<NT));       ENDW(t);   ROT();
    STEP(pA0,pA1,pB0,pB1,t+1,(t+4<NT),(t+2<NT),(t+2<NT));     ENDW(t+1); ROT();
  }
  STEP(pB0,pB1,pA0,pA1,NT-1,false,false,false);
  { float sacc=pB0[0]+pB0[1]; _Pragma("unroll") for(int r=2;r<16;++r)sacc+=pB0[r]; _Pragma("unroll") for(int r=0;r<16;++r)sacc+=pB1[r]; l_reg+=sacc;
    pw0=(u32x4){PKW(pB0,0),PKW(pB0,2),PKW(pB0,4),PKW(pB0,6)};pw1=(u32x4){PKW(pB0,8),PKW(pB0,10),PKW(pB0,12),PKW(pB0,14)};pw2=(u32x4){PKW(pB1,0),PKW(pB1,2),PKW(pB1,4),PKW(pB1,6)};pw3=(u32x4){PKW(pB1,8),PKW(pB1,10),PKW(pB1,12),PKW(pB1,14)};
    SBAR(); pv(o,(int)(unsigned)(uintptr_t)vp0+2*sl_cur,PAF(0),PAF(1),PAF(2),PAF(3)); }
  asm volatile("s_waitcnt lgkmcnt(0)\n\ts_barrier":::"memory");
  #define PREF_NEXT() do{ if(hasn){   \
      const bf16*nks=K+dK+(rowbase+lane_e)*PQ+wid*8; const bf16*nvs=V+dV+(rowbase+16*(wid&3)+(lane_e>>2))*PQ+(wid>>2)*32+(lane_e&3)*8; \
      glds16(nks,(unsigned)__builtin_amdgcn_readfirstlane(kdst)); glds16(nvs,(unsigned)__builtin_amdgcn_readfirstlane(vdst)); glds16(nvs+64,(unsigned)__builtin_amdgcn_readfirstlane(vdst+8192)); \
      glds16(nks+(long)KVBLK*PQ,(unsigned)__builtin_amdgcn_readfirstlane(kdst+SLOTB)); } }while(0)
  #undef PKW
  #undef PAF
  #undef VFR
  #undef WFR
  #undef PIN
  #undef GAPA
  #undef GAPB
  #undef EX
  #undef VRD
  #undef WRD
  #undef KRD
  #undef MF32
  #undef STEP
  #undef ENDW
  int tide=tid; asm volatile("":"+v"(tide)); const int lane_e=tide&63,r32e=lane_e&31,hie=lane_e>>5;
  {auto rr=__builtin_amdgcn_permlane32_swap(__float_as_uint(l_reg),__float_as_uint(l_reg),false,false);l_reg=__uint_as_float(rr[0])+__uint_as_float(rr[1]);}
  if(hie==0)wsf[32+r32e]=l_reg;asm volatile("s_waitcnt lgkmcnt(0)":::"memory");
  float rli[16];
  #pragma unroll
  for(int r=0;r<16;++r)rli[r]=__builtin_amdgcn_rcpf(wsf[32+crow(r,hie)]);
  bf16*Ow=O+(rowbase+q0+wid*QBLK)*PO;
  bf16*stg=(bf16*)(shm+LDS_OST)+wid*2048;
  if(half==0){
    PREF_NEXT();
    #pragma unroll
    for(int dh=0;dh<2;++dh){
      #pragma unroll
      for(int r=0;r<16;++r){const int orow=crow(r,hie);
        #pragma unroll
        for(int d0=0;d0<2;++d0)stg[orow*64+d0*32+r32e]=__float2bfloat16(o[2*dh+d0][r]*rli[r]);}
      asm volatile("s_waitcnt lgkmcnt(0)":::"memory");
      #pragma unroll
      for(int i=0;i<4;++i){const int row=i*8+(lane_e>>3),ch=lane_e&7; const u32x4 v=*(const u32x4*)(stg+row*64+ch*8); ATTN_STORE16(Ow+(long)row*PO+dh*64+ch*8,v);}
      asm volatile("s_waitcnt lgkmcnt(0)":::"memory"); }
  } else {
    float ssr[16];
    #pragma unroll
    for(int r=0;r<16;++r)ssr[r]=0.f;
    asm volatile("s_waitcnt vmcnt(0)":::"memory");
    #pragma unroll
    for(int dh=0;dh<2;++dh){
      #pragma unroll
      for(int i=0;i<4;++i){const int row=i*8+(lane_e>>3),ch=lane_e&7; const u32x4 v=*(const u32x4*)(Ow+(long)row*PO+dh*64+ch*8); *(u32x4*)(stg+row*64+ch*8)=v;}
      asm volatile("s_waitcnt vmcnt(0) lgkmcnt(0)":::"memory");
      #pragma unroll
      for(int r=0;r<16;++r){const int orow=crow(r,hie);
        #pragma unroll
        for(int d0=0;d0<2;++d0){const float o1=__bfloat162float(stg[orow*64+d0*32+r32e]); const float d=o1-lam*(o[2*dh+d0][r]*rli[r]); o[2*dh+d0][r]=d; ssr[r]+=d*d;}}
      asm volatile("s_waitcnt lgkmcnt(0)":::"memory"); }
    PREF_NEXT();
    #pragma unroll
    for(int r=0;r<16;++r){
      #pragma unroll
      for(int mk=1;mk<32;mk<<=1)ssr[r]+=__int_as_float(__builtin_amdgcn_ds_bpermute((lane_e^mk)<<2,__float_as_int(ssr[r])));
      ssr[r]=__builtin_amdgcn_rsqf(ssr[r]*(1.0f/128.0f)+1e-6f)*post;}
    float gsub[4];
    #pragma unroll
    for(int d0=0;d0<4;++d0)gsub[d0]=subg[d0*32+r32e];
    bf16*Yw=Yc+(rowbase+q0+wid*QBLK)*PY;
    #pragma unroll
    for(int dh=0;dh<2;++dh){
      #pragma unroll
      for(int r=0;r<16;++r){const int orow=crow(r,hie);
        #pragma unroll
        for(int d0=0;d0<2;++d0)stg[orow*64+d0*32+r32e]=__float2bfloat16(o[2*dh+d0][r]*ssr[r]*gsub[2*dh+d0]);}
      asm volatile("s_waitcnt lgkmcnt(0)":::"memory");
      #pragma unroll
      for(int i=0;i<4;++i){const int row=i*8+(lane_e>>3),ch=lane_e&7; const u32x4 v=*(const u32x4*)(stg+row*64+ch*8); ATTN_STORE16(Yw+(long)row*PY+dh*64+ch*8,v);}
      asm volatile("s_waitcnt lgkmcnt(0)":::"memory"); }
  }
  asm volatile("s_waitcnt lgkmcnt(0)":::"memory");
  #undef PREF_NEXT
  #undef DMA_K
  #undef DMA_V
  #undef CMASK
  #undef ROT
}
constexpr int ATTN_LDS_BYTES=LDS_BYTES;
struct AttnTensors { const bf16* QKV; bf16* O; bf16* Y; const float* subg; float lam, post; };
struct AttnUnit { int bh; int qb; int half; };
struct StaticOrder {
  int vcu;
  __device__ __forceinline__ explicit StaticOrder(int grid,int block):vcu((block%8)*(grid/8)+block/8){}
  __device__ __forceinline__ bool next(int i,AttnUnit&u)const{ if(i>=4)return false; const int s=vcu&15; u.bh=vcu>>4; u.qb=(i<2)?s:31-s; u.half=i&1; return true; }
};
template<class Sched,int THRL=8> __device__ __forceinline__ void attn_phase(char*lds,const AttnTensors&T,const Sched&S,const int tid_in){
  AttnUnit u,n; int tid=tid_in; asm volatile("":"+v"(tid));
  bool have=S.next(0,u),pre=false;
  for(int i=0;have;++i){
    const bool hn=S.next(i+1,n);
    const int b=u.bh>>2,h=u.bh&3,half=u.half;
    long dK=0,dV=0;
    if(hn){ const int nb=n.bh>>2,nh=n.bh&3; dK=(long)(nb-b)*SEQ*PQ+(nh-h)*128+(n.half-half)*64; dV=(long)(nb-b)*SEQ*PQ+(nh-h)*128; }
    attn_unit<THRL>(b,u.qb,T.QKV+2048+h*128+half*64,T.QKV+2560+h*128+half*64,T.QKV+3072+h*128,T.O+h*256,lds,tid,half,T.lam,T.post,T.subg,T.Y+1024+h*128,hn,dK,dV,pre);
    pre=hn; u=n; have=hn; }
}
#undef SBAR
#undef WAIT_BAR
}
#include <hip/hip_cooperative_groups.h>
namespace cg = cooperative_groups;
constexpr int NWAVES = 8;
#ifndef MK_SPLIT
#define MK_SPLIT 0
#endif
constexpr int NB = 4, SEQ = 8192, T = NB * SEQ, D = 1024, DIN = 6656, MIXW = 512, FF = 4096, PLE = 256, NL = 2;
constexpr int P1W = 3584, GTW = 3072, YW = 1536;
constexpr int PH_PER_LAYER = 12, NPHASE = NL * PH_PER_LAYER;
constexpr float EPS = 1e-6f;
constexpr float QSCALE = 0.125f * 1.4426950408889634f;

constexpr size_t MiB = 1u << 20;
constexpr size_t WS_WIN = 1 * MiB, WS_WM = 14 * MiB, WS_WO = 17 * MiB, WS_WUP = 19 * MiB, WS_WDN = 27 * MiB, WS_WG = 35 * MiB, WS_WP = 37 * MiB;
constexpr size_t WS_XB = 38 * MiB;
constexpr size_t WS_P1 = 102 * MiB;
constexpr size_t WS_Y = 326 * MiB;
constexpr size_t WS_O = 422 * MiB;
constexpr size_t WS_PB = 486 * MiB;
constexpr size_t WS_SSP = 502 * MiB;
constexpr size_t WS_SSX = 510 * MiB;
constexpr size_t WS_END = 512 * MiB;
constexpr size_t WS_UP = 102 * MiB;
static_assert(WS_XB + (size_t)T * D * 2 <= WS_P1 && WS_P1 + (size_t)T * P1W * 2 <= WS_Y && WS_Y + (size_t)T * YW * 2 <= WS_O && WS_O + (size_t)T * D * 2 <= WS_PB && WS_PB + (size_t)T * PLE * 2 <= WS_END, "ws map");
static_assert(WS_UP + (size_t)T * FF * 2 <= WS_O && WS_WP + (size_t)D * PLE * 2 <= WS_XB && WS_WIN + (size_t)DIN * D * 2 <= WS_WM, "ws map 2");

constexpr int RING_BYTES = 131072, LDS_BYTES = 147456;

#define GAS __attribute__((address_space(1)))
#define LAS __attribute__((address_space(3)))
typedef unsigned short bf16;
typedef unsigned v4u __attribute__((ext_vector_type(4)));
typedef unsigned v2u __attribute__((ext_vector_type(2)));
typedef float f32x4 __attribute__((ext_vector_type(4)));
#define LDS_WAIT() asm volatile("s_waitcnt lgkmcnt(0)" ::: "memory")
__device__ __forceinline__ unsigned f2bf(float f) { unsigned u = __builtin_bit_cast(unsigned, f); return (u + 0x7fffu + ((u >> 16) & 1u)) >> 16; }
__device__ __forceinline__ unsigned pk2(float lo, float hi) { return f2bf(lo) | (f2bf(hi) << 16); }
__device__ __forceinline__ float shx(float v, int m, int lane) { return __int_as_float(__builtin_amdgcn_ds_bpermute((lane ^ m) << 2, __float_as_int(v))); }
__device__ __forceinline__ float wave_sum(float v, int lane) {
#pragma unroll
    for (int o = 1; o < 64; o <<= 1) v += shx(v, o, lane);
    return v;
}
__device__ __forceinline__ void up8(const v4u w, float (&f)[8]) {
#pragma unroll
    for (int i = 0; i < 4; ++i) { f[2 * i] = __uint_as_float(w[i] << 16); f[2 * i + 1] = __uint_as_float(w[i] & 0xffff0000u); }
}
__device__ __forceinline__ v4u pk8(const float (&f)[8]) { v4u w; w.x = pk2(f[0], f[1]); w.y = pk2(f[2], f[3]); w.z = pk2(f[4], f[5]); w.w = pk2(f[6], f[7]); return w; }

#define RLX_AGENT __ATOMIC_RELAXED, __HIP_MEMORY_SCOPE_AGENT
constexpr int CW_BAR = 4096;
constexpr size_t CTL_ZERO_BYTES = 1u << 20, WS_SS = 65536;
constexpr int MISC_OFF = RING_BYTES + 320;
#define XB_TMO      128
#define XB_XCNT(j)  (256  + 64 * (j))
#define XB_XSUB(j)  (1280 + 64 * (j))
#define XB_XGEN(j)  (2304 + 64 * (j))
#define XB_TOP      3328
#define XB_TOPGEN   3392
#define XCD_BAR_WORDS 3456
#define XB_SPIN_CAP (1u << 18)

__device__ __forceinline__ unsigned xb_ld(unsigned* p)              { return __hip_atomic_load(p, __ATOMIC_RELAXED, __HIP_MEMORY_SCOPE_AGENT); }
__device__ __forceinline__ unsigned xb_add(unsigned* p, unsigned v) { return __hip_atomic_fetch_add(p, v, __ATOMIC_RELAXED, __HIP_MEMORY_SCOPE_AGENT); }
__device__ __forceinline__ unsigned xb_xcc_id() { return (unsigned)__builtin_amdgcn_s_getreg((3 << 11) | 20) & 0xFu; }
#define XB_SPIN(cond, bar) do { unsigned _sp = 0; while (cond) { __builtin_amdgcn_s_sleep(1); \
    if ((++_sp & 255u) == 0u) { if (xb_ld(&(bar)[XB_TMO])) break; if (_sp > XB_SPIN_CAP) { atomicAdd(&(bar)[XB_TMO], 1u); break; } } } } while (0)

struct XcdBarrier {
    unsigned* bar; unsigned x;
    volatile LAS unsigned* st;
};

__device__ __forceinline__ XcdBarrier xcd_barrier_post(unsigned* bar, volatile LAS unsigned* st) {
    XcdBarrier b; b.bar = bar; b.x = xb_xcc_id(); b.st = st;
    if (threadIdx.x == 0) (void)xb_add(&bar[XB_XCNT(b.x)], 1u);
    return b;
}
__device__ __forceinline__ void xcd_barrier_complete(unsigned* bar, unsigned x, unsigned& nloc, unsigned& nx) {
    const unsigned G = gridDim.x * gridDim.y * gridDim.z;
    unsigned sum, cnt, mine, sp = 0u;
    for (;;) {
        sum = 0u; cnt = 0u; mine = 0u;
#pragma unroll
        for (unsigned j = 0; j < 16; ++j) { const unsigned c = xb_ld(&bar[XB_XCNT(j)]); sum += c; cnt += (c > 0u) ? 1u : 0u; mine = (j == x) ? c : mine; }
        if (sum == G) break;
        __builtin_amdgcn_s_sleep(1);
        if ((++sp & 255u) == 0u) { if (xb_ld(&bar[XB_TMO])) break; if (sp > XB_SPIN_CAP) { atomicAdd(&bar[XB_TMO], 1u); break; } }
    }
    nloc = mine > 0u ? mine : 1u; nx = cnt > 0u ? cnt : 1u;
}

__device__ __forceinline__ void xcd_barrier(const XcdBarrier& b, const bool leader) {
    asm volatile("s_waitcnt vmcnt(0)" ::: "memory");
    __syncthreads();
    if (leader) {
        unsigned* bar = b.bar;
        __builtin_amdgcn_s_waitcnt(0);
        unsigned nloc = b.st[0], nx = b.st[1];
        if (nloc == 0u) { xcd_barrier_complete(bar, b.x, nloc, nx); b.st[0] = nloc; b.st[1] = nx; }
        const unsigned old = xb_add(&bar[XB_XSUB(b.x)], 1u);
        const unsigned gen = old / nloc;
        if (old + 1u == (gen + 1u) * nloc) {
            __builtin_amdgcn_fence(__ATOMIC_RELEASE, "agent");
            asm volatile("s_waitcnt vmcnt(0)" ::: "memory");
            const unsigned og = xb_add(&bar[XB_TOP], 1u);
            const unsigned tg = og / nx;
            if (og + 1u == (tg + 1u) * nx) xb_add(&bar[XB_TOPGEN], 1u);
            else XB_SPIN(xb_ld(&bar[XB_TOPGEN]) == tg, bar);
            __builtin_amdgcn_fence(__ATOMIC_ACQUIRE, "agent");
            xb_add(&bar[XB_XGEN(b.x)], 1u);
            asm volatile("s_waitcnt vmcnt(0)" ::: "memory");
        } else {
            XB_SPIN(xb_ld(&bar[XB_XGEN(b.x)]) == gen, bar);
            __builtin_amdgcn_fence(__ATOMIC_ACQUIRE, "agent");
            asm volatile("s_waitcnt vmcnt(0)" ::: "memory");
        }
    }
    __syncthreads();
}

__device__ __forceinline__ void p0_transpose_item(const float* W, int K, int N, bf16* WT, LAS float* scr, int item, int lane, const float* gk = nullptr, const bool permqk = false) {
    const int nblk = N / 32, kb = item / nblk, nb = item % nblk, k0 = 64 * kb, n0 = 32 * nb;
    float wv[32];
#pragma unroll
    for (int i = 0; i < 32; ++i) wv[i] = W[(size_t)(k0 + 2 * i + (lane >> 5)) * N + n0 + (lane & 31)] * (gk ? gk[k0 + 2 * i + (lane >> 5)] : 1.f);
#pragma unroll
    for (int i = 0; i < 32; ++i) scr[(2 * i + (lane >> 5)) * 33 + (lane & 31)] = wv[i];
    LDS_WAIT(); asm volatile("" ::: "memory");
    const int c = lane & 7;
    int nout0 = n0; if (permqk && n0 >= 2048 && n0 < 3072) { const int lb = (n0 >> 5) & 7; nout0 = (n0 & ~255) + (((lb & 1) * 4 + (lb >> 1)) << 5); }
#pragma unroll
    for (int j = 0; j < 4; ++j) { const int n = (lane >> 3) + 8 * j; const LAS float* s = scr + (8 * c) * 33 + n;
        v4u o; o.x = pk2(s[0 * 33], s[1 * 33]); o.y = pk2(s[2 * 33], s[3 * 33]); o.z = pk2(s[4 * 33], s[5 * 33]); o.w = pk2(s[6 * 33], s[7 * 33]);
        *(v4u*)(WT + (size_t)(nout0 + n) * K + k0 + 8 * c) = o; }
    LDS_WAIT(); asm volatile("" ::: "memory");
}
__device__ __forceinline__ void row_to_bf16_ss(const float* xrow, bf16* orow, float* ssp, int lane) {
    const f32x4* xr = (const f32x4*)xrow + lane;
    f32x4 v[4]; float s = 0.f;
#pragma unroll
    for (int j = 0; j < 4; ++j) { v[j] = xr[64 * j]; s += (v[j].x * v[j].x + v[j].y * v[j].y) + (v[j].z * v[j].z + v[j].w * v[j].w); }
    s = wave_sum(s, lane);
    v2u* o8 = (v2u*)orow + lane;
#pragma unroll
    for (int j = 0; j < 4; ++j) { v2u o; o.x = pk2(v[j].x, v[j].y); o.y = pk2(v[j].z, v[j].w); o8[64 * j] = o; }
    if (lane == 0) *ssp = s;
}
__device__ __forceinline__ void rms_row_to_bf16(const float* xrow, const float* g, bf16* orow, int lane) {
    const f32x4* xr = (const f32x4*)xrow + lane; const f32x4* gr = (const f32x4*)g + lane;
    f32x4 v[4]; float s = 0.f;
#pragma unroll
    for (int j = 0; j < 4; ++j) { v[j] = xr[64 * j]; s += (v[j].x * v[j].x + v[j].y * v[j].y) + (v[j].z * v[j].z + v[j].w * v[j].w); }
    const float rstd = 1.f / sqrtf(wave_sum(s, lane) * (1.f / D) + EPS);
    v2u* o8 = (v2u*)orow + lane;
#pragma unroll
    for (int j = 0; j < 4; ++j) { const f32x4 gv = gr[64 * j]; v2u o; o.x = pk2(v[j].x * rstd * gv.x, v[j].y * rstd * gv.y); o.y = pk2(v[j].z * rstd * gv.z, v[j].w * rstd * gv.w); o8[64 * j] = o; }
}

struct Args { const float* in[24]; float* out; unsigned char* ws; int ph_lo, ph_hi; };

__global__ void __launch_bounds__(NWAVES * 64, 2) fwd_mega(Args args) {
    extern __shared__ __attribute__((aligned(16))) unsigned char lds[];
    cg::grid_group grid = cg::this_grid();
#define PH_BEGIN \
    int tid = MYTID(); asm volatile("" : "+v"(tid)); \
    int G = gridDim.x, bx = blockIdx.x; asm volatile("" : "+s"(G), "+s"(bx)); \
    unsigned char* ws = args.ws; float* out = args.out; asm volatile("" : "+s"(ws), "+s"(out)); \
    const int lane = tid & 63, wave = __builtin_amdgcn_readfirstlane(tid >> 6); \
    const int vcu = (bx % 8) * (G / 8) + bx / 8; \
    const int gw = vcu * NWAVES + wave, NGW = G * NWAVES, gt = vcu * (NWAVES * 64) + tid, NGT = G * NWAVES * 64; \
    LAS unsigned char* ldsp = (LAS unsigned char*)lds; \
    (void)lane; (void)gw; (void)NGW; (void)gt; (void)NGT; (void)ldsp; (void)out; (void)ws;
#define Win_t ((bf16*)(ws + WS_WIN))
#define WM_t ((bf16*)(ws + WS_WM))
#define Wo_t ((bf16*)(ws + WS_WO))
#define Wup_t ((bf16*)(ws + WS_WUP))
#define Wdn_t ((bf16*)(ws + WS_WDN))
#define Wg_t ((bf16*)(ws + WS_WG))
#define Wp_t ((bf16*)(ws + WS_WP))
#define XB ((bf16*)(ws + ((L & 1) ? WS_O : WS_XB)))
#define P1 ((bf16*)(ws + WS_P1))
#define Yb ((bf16*)(ws + WS_Y))
#define Ob ((bf16*)(ws + ((L & 1) ? WS_XB : WS_O)))
#define PB ((bf16*)(ws + WS_PB))
#define UP ((bf16*)(ws + WS_UP))
    const int wave_s = __builtin_amdgcn_readfirstlane((int)threadIdx.x >> 6);
#define MYTID() ({ unsigned z_; asm volatile("v_mov_b32 %0, 0" : "=v"(z_)); wave_s * 64 + (int)__builtin_amdgcn_mbcnt_hi(~0u, __builtin_amdgcn_mbcnt_lo(~0u, z_)); })
    volatile LAS unsigned* MISC = (volatile LAS unsigned*)((LAS unsigned char*)lds + MISC_OFF);
    if (threadIdx.x < 32) MISC[threadIdx.x] = 0u;
    __syncthreads();
    const int lo = args.ph_lo, hi = args.ph_hi;
    if (lo == 0) {
        unsigned char* ws0 = args.ws;
        if (blockIdx.x == 0) for (int i = threadIdx.x; i < XCD_BAR_WORDS; i += NWAVES * 64) ((unsigned*)ws0 + CW_BAR)[i] = 0u;
    }
#define IN(k) (lo <= (k) && (k) < hi)
#ifndef PHMASK
#define PHMASK 0xfff
#endif
#define PH_ON(j) (((PHMASK) >> (j)) & 1)
#define SEAM(k) do { if (IN(k) && IN((k) + 1)) { if ((k) == 0) { asm volatile("s_waitcnt vmcnt(0)" ::: "memory"); __syncthreads(); grid.sync(); (void)xcd_barrier_post((unsigned*)args.ws + CW_BAR, (volatile LAS unsigned*)((LAS unsigned char*)lds + MISC_OFF) + 8); } else { XcdBarrier bar_; bar_.bar = (unsigned*)args.ws + CW_BAR; bar_.x = xb_xcc_id(); bar_.st = (volatile LAS unsigned*)((LAS unsigned char*)lds + MISC_OFF) + 8; xcd_barrier(bar_, MYTID() == 0); } } } while (0)

    for (int L = 0; L < NL; ++L) {
        const int pb = L * PH_PER_LAYER;
#define LP(idx, stride) (args.in[idx] + (size_t)L * (stride))
#define hsrc ((L == 0) ? args.in[0] : (const float*)out)
#define SSP0 ((float*)(ws + WS_SS) + (size_t)L * T)
#define SSP(j) ((float*)(ws + WS_SSP) + (size_t)(2 * L + (j) - 1) * T * 16)
#define p_in LP(1, (size_t)T * PLE)
#define g_mix LP(2, D)
#define w_in LP(3, (size_t)D * DIN)
#define pool_w LP(4, 4 * 128 * 128)
#define pool_scale LP(5, MIXW)
#define conv_w LP(6, 3 * MIXW)
#define qg LP(7, 64)
#define kg LP(8, 64)
#define lq1 LP(9, 64)
#define lk1 LP(10, 64)
#define lq2 LP(11, 64)
#define lk2 LP(12, 64)
#define subg LP(13, 128)
#define w_pool_out LP(14, (size_t)MIXW * D)
#define w_conv_out LP(15, (size_t)MIXW * D)
#define w_attn_out LP(16, (size_t)MIXW * D)
#define w_o LP(17, (size_t)D * D)
#define g_mlp LP(18, D)
#define w_up LP(19, (size_t)D * FF)
#define w_down LP(20, (size_t)FF * D)
#define g_ple LP(21, D)
#define w_gate LP(22, (size_t)D * D)
#define w_proj LP(23, (size_t)PLE * D)
        const float lam_init = (L == 0) ? 0.2f : 0.35550906759096940f;

        if (PH_ON(0) && IN(pb + 0)) { PH_BEGIN
            {
                const int n = gt & 1023, kgrp = __builtin_amdgcn_readfirstlane(gt >> 10), k0 = kgrp * 4, gI = k0 >> 7;
                const float* wp = w_pool_out + (size_t)(gI * 128) * D + n; const float* sc = pool_scale + gI * 128; const float* pw = pool_w + (size_t)k0 * 128;
                float a[8];
#pragma unroll
                for (int j = 0; j < 8; ++j) a[j] = 0.f;
                for (int d0 = 0; d0 < 128; d0 += 8) {
                    float w[8];
#pragma unroll
                    for (int dd = 0; dd < 8; ++dd) w[dd] = wp[(size_t)(d0 + dd) * D];
#pragma unroll
                    for (int dd = 0; dd < 8; ++dd) w[dd] *= sc[d0 + dd];
#pragma unroll
                    for (int j = 0; j < 4; ++j)
#pragma unroll
                        for (int dd = 0; dd < 8; ++dd) a[j] += pw[j * 128 + d0 + dd] * w[dd];
                }
                v2u o; o.x = pk2(a[0], a[1]); o.y = pk2(a[2], a[3]);
                if (gt < 131072) *(v2u*)(WM_t + (size_t)n * MIXW + k0) = o;
            }
            LAS float* scr = (LAS float*)((LAS unsigned char*)lds + wave * 16384);
            constexpr int I_IN = (D / 64) * (DIN / 32), I_M = (MIXW / 64) * (D / 32), I_O = (D / 64) * (D / 32), I_UP = (D / 64) * (FF / 32), I_DN = (FF / 64) * (D / 32), I_P = (PLE / 64) * (D / 32);
            constexpr int NITEMS = I_IN + 2 * I_M + 2 * I_O + I_UP + I_DN + I_P;
            for (int it = gw; it < NITEMS; it += NGW) {
                int r = it;
                if (r < I_IN) { p0_transpose_item(w_in, D, DIN, Win_t, scr, r, lane, g_mix, true); continue; } r -= I_IN;
                if (r < I_M) { p0_transpose_item(w_conv_out, MIXW, D, WM_t + (size_t)D * MIXW, scr, r, lane); continue; } r -= I_M;
                if (r < I_M) { p0_transpose_item(w_attn_out, MIXW, D, WM_t + (size_t)2 * D * MIXW, scr, r, lane); continue; } r -= I_M;
                if (r < I_O) { p0_transpose_item(w_o, D, D, Wo_t, scr, r, lane); continue; } r -= I_O;
                if (r < I_O) { p0_transpose_item(w_gate, D, D, Wg_t, scr, r, lane, g_ple); continue; } r -= I_O;
                if (r < I_UP) { p0_transpose_item(w_up, D, FF, Wup_t, scr, r, lane, g_mlp); continue; } r -= I_UP;
                if (r < I_DN) { p0_transpose_item(w_down, FF, D, Wdn_t, scr, r, lane); continue; } r -= I_DN;
                p0_transpose_item(w_proj, PLE, D, Wp_t, scr, r, lane);
            }
            if (L == 0) { for (int m = gw; m < T; m += NGW) row_to_bf16_ss(hsrc + (size_t)m * D, XB + (size_t)m * D, SSP0 + m, lane); }
            else { for (int m = gt; m < T; m += NGT) SSP0[m] = pg8::sum16((const float*)(ws + WS_SSX) + (size_t)m * 16); }
            for (int c = gt; c < T * PLE / 8; c += NGT) { const f32x4 a = *(const f32x4*)(p_in + (size_t)c * 8), b = *(const f32x4*)(p_in + (size_t)c * 8 + 4);
                v4u o; o.x = pk2(a.x, a.y); o.y = pk2(a.z, a.w); o.z = pk2(b.x, b.y); o.w = pk2(b.z, b.w); *(v4u*)(PB + (size_t)c * 8) = o; }
            __syncthreads();
        }
        SEAM(pb + 0);

        if (PH_ON(1) && IN(pb + 1)) { PH_BEGIN
            pg8::Gemm g{XB, Win_t, T, P1W, D, D, D}; pg8::StaticOrder S; S.init(T, P1W, G, bx);
            pg8::EpiAct<0, 1> E{P1, P1W, SSP0, qg, kg, QSCALE};
            pg8::gemm_phase<pg8::EpiAct<0, 1>, pg8::StaticOrder, true, true>(ldsp, g, S, E, tid);
        }
        SEAM(pb + 1);

        if (PH_ON(2) && IN(pb + 2)) { PH_BEGIN
            const int c8 = 8 * lane, grp = lane >> 4;
            const int win = 2 << grp;
            float cw[3][8];
#pragma unroll
            for (int j = 0; j < 3; ++j) { const f32x4 w0 = *(const f32x4*)(conv_w + (2 - j) * MIXW + c8), w1 = *(const f32x4*)(conv_w + (2 - j) * MIXW + c8 + 4);
                cw[j][0] = w0.x; cw[j][1] = w0.y; cw[j][2] = w0.z; cw[j][3] = w0.w; cw[j][4] = w1.x; cw[j][5] = w1.y; cw[j][6] = w1.z; cw[j][7] = w1.w; }
            const int t0 = vcu * 128 + wave * 16, s0 = t0 & (SEQ - 1);
            const bf16* base = P1 + (size_t)t0 * P1W;
            const float hv = (s0 == 0) ? 0.f : 1.f;
            {
                v4u pa[31];
#pragma unroll
                for (int i = 0; i < 31; ++i) { const bool ok = (i >= 15) || (s0 != 0); pa[i] = *(const v4u*)(base + (ok ? (ptrdiff_t)(i - 15) * P1W : (ptrdiff_t)0) + c8); }
                float W[8], v[8];
#pragma unroll
                for (int e = 0; e < 8; ++e) W[e] = 0.f;
#pragma unroll
                for (int j = 1; j < 16; ++j) { const float mj = (j < win) ? hv : 0.f; up8(pa[15 - j], v);
#pragma unroll
                    for (int e = 0; e < 8; ++e) W[e] += mj * v[e]; }
#pragma unroll
                for (int r = 0; r < 16; ++r) {
                    float cur[8]; up8(pa[15 + r], cur);
#pragma unroll
                    for (int e = 0; e < 8; ++e) W[e] += cur[e];
                    if (r >= 1) {
                        v4u sel;
#pragma unroll
                        for (int q = 0; q < 4; ++q) { const unsigned x2 = pa[13 + r][q], x4 = (r + 11 >= 0 && r + 11 < 31) ? pa[11 + r][q] : 0u, x8 = pa[7 + r][q], x16 = pa[r - 1][q];
                            sel[q] = (grp == 0) ? x2 : (grp == 1) ? x4 : (grp == 2) ? x8 : x16; }
                        const float ml = (r >= win) ? 1.f : hv; up8(sel, v);
#pragma unroll
                        for (int e = 0; e < 8; ++e) W[e] -= ml * v[e];
                    }
                    const int sp1 = s0 + r + 1; const float inv = 1.f / (float)((sp1 < win) ? sp1 : win);
                    float o[8];
#pragma unroll
                    for (int e = 0; e < 8; ++e) o[e] = W[e] * inv - cur[e];
                    *(v4u*)(Yb + (size_t)(t0 + r) * YW + c8) = pk8(o);
                }
            }
            {
                float z1[8], z2[8], cx[8], cc[8];
                {   const v4u a1 = *(const v4u*)(base - (s0 != 0 ? (ptrdiff_t)P1W : (ptrdiff_t)0) + 512 + c8), b1 = *(const v4u*)(base - (s0 != 0 ? (ptrdiff_t)P1W : (ptrdiff_t)0) + 1536 + c8);
                    const v4u a2 = *(const v4u*)(base - (s0 != 0 ? (ptrdiff_t)2 * P1W : (ptrdiff_t)0) + 512 + c8), b2 = *(const v4u*)(base - (s0 != 0 ? (ptrdiff_t)2 * P1W : (ptrdiff_t)0) + 1536 + c8);
                    up8(a1, cx); up8(b1, cc);
#pragma unroll
                    for (int e = 0; e < 8; ++e) z1[e] = hv * cc[e] * cx[e];
                    up8(a2, cx); up8(b2, cc);
#pragma unroll
                    for (int e = 0; e < 8; ++e) z2[e] = hv * cc[e] * cx[e]; }
#pragma unroll
                for (int rb = 0; rb < 16; rb += 8) {
                    v4u xv[8], cv[8], bv[8];
#pragma unroll
                    for (int i = 0; i < 8; ++i) { const bf16* pr = base + (size_t)(rb + i) * P1W; xv[i] = *(const v4u*)(pr + 512 + c8); bv[i] = *(const v4u*)(pr + 1024 + c8); cv[i] = *(const v4u*)(pr + 1536 + c8); }
#pragma unroll
                    for (int i = 0; i < 8; ++i) { float z0[8], cb[8], o[8]; up8(xv[i], cx); up8(cv[i], cc); up8(bv[i], cb);
#pragma unroll
                        for (int e = 0; e < 8; ++e) { z0[e] = cc[e] * cx[e]; o[e] = cb[e] * (cw[0][e] * z0[e] + cw[1][e] * z1[e] + cw[2][e] * z2[e]); z2[e] = z1[e]; z1[e] = z0[e]; }
                        *(v4u*)(Yb + (size_t)(t0 + rb + i) * YW + 512 + c8) = pk8(o); }
                }
            }
        }

        if (PH_ON(3) && IN(pb + 3)) { PH_BEGIN
            const float s1 = wave_sum(lq1[lane] * lk1[lane], lane), s2 = wave_sum(lq2[lane] * lk2[lane], lane);
            const float lam = __expf(s1) - __expf(s2) + lam_init;
            const attn_body::AttnTensors AT{(const attn_body::bf16*)P1, (attn_body::bf16*)Ob, (attn_body::bf16*)Yb, subg, lam, 1.f - lam_init};
            const attn_body::StaticOrder S(G, bx);
            attn_body::attn_phase<attn_body::StaticOrder>((char*)lds, AT, S, tid);
        }
        SEAM(pb + 3);

        if (PH_ON(4) && IN(pb + 4)) { PH_BEGIN
            pg8::Gemm g{XB, Win_t + (size_t)P1W * D, T, GTW, D, D, D}; pg8::StaticOrder S; S.init(T, GTW, G, bx);
            pg8::EpiAct<1, 1> E{P1, GTW, SSP0};
            pg8::gemm_phase<pg8::EpiAct<1, 1>, pg8::StaticOrder, true, true>(ldsp, g, S, E, tid);
        }
        SEAM(pb + 4);

        if (PH_ON(5) && IN(pb + 5)) { PH_BEGIN
            pg8::SegOrder S; S.base.init(T, D, G, bx);
            pg8::Gemm g{Yb, WM_t, T, D, MIXW, YW, MIXW, (size_t)MIXW * 2, (size_t)D * MIXW * 2};
            pg8::EpiMergeR E{P1, Ob};
            pg8::gemm_phase<pg8::EpiMergeR, pg8::SegOrder, true, true>(ldsp, g, S, E, tid);
        }
        SEAM(pb + 5);

        if (PH_ON(6) && IN(pb + 6)) { PH_BEGIN
            pg8::Gemm g{Ob, Wo_t, T, D, D, D, D}; pg8::StaticOrder S; S.init(T, D, G, bx);
            pg8::EpiResidN E{(L == 0) ? args.in[0] : (const float*)nullptr, XB, SSP(1)};
            pg8::gemm_phase<pg8::EpiResidN, pg8::StaticOrder, true, true>(ldsp, g, S, E, tid);
        }
        SEAM(pb + 6);


        if (PH_ON(8) && IN(pb + 8)) { PH_BEGIN
            { pg8::Gemm g{PB, Wp_t, T, D, PLE, PLE, PLE}; pg8::StaticOrder S; S.init(T, D, G, bx);
              pg8::EpiAct<0, 0> E{Ob, D, nullptr};
              pg8::gemm_phase<pg8::EpiAct<0, 0>, pg8::StaticOrder, true, true>(ldsp, g, S, E, tid); }
            pg8::Gemm g{XB, Wup_t, T, FF, D, D, D}; pg8::StaticOrder S; S.init(T, FF, G, bx);
            pg8::EpiAct<2, 2> E{UP, FF, SSP(1)};
            pg8::gemm_phase<pg8::EpiAct<2, 2>, pg8::StaticOrder, true, true>(ldsp, g, S, E, tid);
        }
        SEAM(pb + 8);

        if (PH_ON(9) && IN(pb + 9)) { PH_BEGIN
            pg8::Gemm g{UP, Wdn_t, T, D, FF, FF, FF}; pg8::StaticOrder S; S.init(T, D, G, bx);
            pg8::EpiResidN E{nullptr, XB, SSP(2)};
            pg8::gemm_phase<pg8::EpiResidN, pg8::StaticOrder, true, true>(ldsp, g, S, E, tid);
        }
        SEAM(pb + 9);


        if (PH_ON(11) && IN(pb + 11)) { PH_BEGIN
            pg8::Gemm g{XB, Wg_t, T, D, D, D, D}; pg8::StaticOrder S; S.init(T, D, G, bx);
            pg8::EpiPle E{XB, (L == NL - 1) ? out : (float*)nullptr, Ob, SSP(2), (float*)(ws + WS_SSX)};
            pg8::gemm_phase<pg8::EpiPle, pg8::StaticOrder, true, true>(ldsp, g, S, E, tid);
        }
        SEAM(pb + 11);
    }
#undef IN
#undef SEAM
}

extern "C" void kernel_launch(void* const* d_in, const int* in_sizes, int n_in, void* d_out, int out_size, void* d_ws, size_t ws_size, hipStream_t stream) {
    static int grid = 0;
    if (grid == 0) {
        if (n_in != 24 || in_sizes[0] != T * D || out_size != T * D || ws_size < WS_END) { fprintf(stderr, "kernel_launch: unexpected shapes / workspace (n_in %d, in0 %d, out %d, ws %zu < %zu); nothing launched\n", n_in, n_in > 0 ? in_sizes[0] : -1, out_size, ws_size, (size_t)WS_END); grid = -1; return; }
        int dev = 0, cus = 0, per_cu = 0;
        if (hipGetDevice(&dev) != hipSuccess || hipDeviceGetAttribute(&cus, hipDeviceAttributeMultiprocessorCount, dev) != hipSuccess) { grid = -1; return; }
        if (hipFuncSetAttribute((const void*)fwd_mega, hipFuncAttributeMaxDynamicSharedMemorySize, LDS_BYTES) != hipSuccess) { fprintf(stderr, "kernel_launch: hipFuncSetAttribute failed\n"); grid = -1; return; }
        if (hipOccupancyMaxActiveBlocksPerMultiprocessor(&per_cu, (const void*)fwd_mega, NWAVES * 64, LDS_BYTES) != hipSuccess) per_cu = 0;
        (void)hipGetLastError();
        if (cus * per_cu < 256) { fprintf(stderr, "kernel_launch: resident capacity %d x %d < 256 workgroups; nothing launched\n", cus, per_cu); grid = -1; return; }
        grid = 256;
    }
    if (grid < 0) return;
    Args a{};
    for (int i = 0; i < 24; ++i) a.in[i] = (const float*)d_in[i];
    a.out = (float*)d_out; a.ws = (unsigned char*)d_ws;
#if MK_SPLIT
    for (int ph = 0; ph < NPHASE; ++ph) { a.ph_lo = ph; a.ph_hi = ph + 1; hipLaunchKernelGGL(fwd_mega, dim3(grid), dim3(NWAVES * 64), LDS_BYTES, stream, a); }
#else
    a.ph_lo = 0; a.ph_hi = NPHASE;
    void* kargs[] = {&a};
    const hipError_t e = hipLaunchCooperativeKernel((const void*)fwd_mega, dim3(grid), dim3(NWAVES * 64), kargs, LDS_BYTES, stream);
    if (e != hipSuccess) fprintf(stderr, "kernel_launch: cooperative launch failed: %s\n", hipGetErrorString(e));
#endif
}
```

```cpp
#include <hip/hip_runtime.h>
#include <cstdio>
#include <cstdint>
namespace pg8 {
#define PG8_LAS __attribute__((address_space(3)))
typedef unsigned short bf16_t;
typedef short bf16x8 __attribute__((ext_vector_type(8)));
typedef float f32x4 __attribute__((ext_vector_type(4)));
typedef unsigned u32x4 __attribute__((ext_vector_type(4)));
constexpr int BM = 256, BK = 64, HALF = 128, HTB = HALF * BK * 2  , STAGE_BYTES = 8 * HTB, NXCD = 8, WGM = 8;

__host__ __device__ __forceinline__ int lds_byte(int r, int c) { const int st = (r >> 4) * 2 + (c >> 5), rr = r & 15, cc = c & 31, ob = rr * 64 + cc * 2; return st * 1024 + (ob ^ (((ob >> 9) & 1) << 5)); }
__host__ __device__ __forceinline__ void stage_rc(int b, int& R, int& C) { const int st = b / 1024, sb = b % 1024, swz = sb ^ (((sb >> 9) & 1) << 5); R = (st >> 1) * 16 + swz / 64; C = (st & 1) * 32 + (swz % 64) / 2; }
__host__ __device__ __forceinline__ int perm32(int rho) { const int n = rho >> 4, i = rho & 15; return 8 * (i >> 2) + 4 * n + (i & 3); }

struct Unit { int pm, pn, seg = 0; };
struct Gemm { const bf16_t* A; const bf16_t* Bt; int M, N, K, lda, ldb; size_t segA = 0, segB = 0; };

struct StaticOrder {
    int nM, nN, nwg, G, c;
    __host__ __device__ void init(int M, int N, int G_, int c_) { nM = M / BM; nN = N / BM; nwg = nM * nN; G = G_; c = c_; }
    __host__ __device__ bool next(int i, Unit& u) const {
        const long L = (long)i * G + c; if (L >= nwg) return false;
        int wgid = (int)L; { const int q = nwg / NXCD, r = nwg % NXCD, xcd = wgid % NXCD, off = wgid / NXCD; wgid = (xcd < r ? xcd * (q + 1) : r * (q + 1) + (xcd - r) * q) + off; }
        const int nig = WGM * nN, gid = wgid / nig, fm = gid * WGM, gsz = (nM - fm) < WGM ? (nM - fm) : WGM;
        u.pm = fm + ((wgid % nig) % gsz); u.pn = (wgid % nig) / gsz; return true;
    }
    __device__ __forceinline__ void a_ready(const Unit&) const {}
    __device__ __forceinline__ void done(const Unit&) const {}
};

typedef float f32x2_cv __attribute__((ext_vector_type(2))); typedef __bf16 bf16x2_cv __attribute__((ext_vector_type(2)));
__device__ __forceinline__ unsigned cvt_pk_bf16(float lo, float hi) { const f32x2_cv v = {lo, hi}; const bf16x2_cv b = __builtin_convertvector(v, bf16x2_cv); return __builtin_bit_cast(unsigned, b); }
typedef float f32x2 __attribute__((ext_vector_type(2)));
struct SegOrder {
    StaticOrder base;
    __host__ __device__ bool next(int i, Unit& u) const { if (!base.next(i / 3, u)) return false; u.seg = i - 3 * (i / 3); return true; }
    __device__ __forceinline__ void a_ready(const Unit&) const {}
    __device__ __forceinline__ void done(const Unit&) const {}
};
typedef unsigned short u16_t;
__device__ __forceinline__ float sigmoid_f(float x) { return __builtin_amdgcn_rcpf(1.0f + __builtin_amdgcn_exp2f(-1.4426950408889634f * x)); }
__device__ __forceinline__ void unpack8(const u32x4 w, float (&f)[8]) {
#pragma unroll
    for (int i = 0; i < 4; ++i) { f[2 * i] = __uint_as_float(w[i] << 16); f[2 * i + 1] = __uint_as_float(w[i] & 0xffff0000u); }
}
__device__ __forceinline__ u32x4 pack8(const float (&f)[8]) { u32x4 w; w.x = cvt_pk_bf16(f[0], f[1]); w.y = cvt_pk_bf16(f[2], f[3]); w.z = cvt_pk_bf16(f[4], f[5]); w.w = cvt_pk_bf16(f[6], f[7]); return w; }

__device__ __forceinline__ float rstd_of(float ss) { return __builtin_amdgcn_rsqf(ss * (1.0f / 1024.0f) + 1e-6f); }
__device__ __forceinline__ float sum16(const float* p) { const f32x4 a = *(const f32x4*)p, b = *(const f32x4*)(p + 4), c = *(const f32x4*)(p + 8), d = *(const f32x4*)(p + 12);
    return (((a[0] + a[1]) + (a[2] + a[3])) + ((b[0] + b[1]) + (b[2] + b[3]))) + (((c[0] + c[1]) + (c[2] + c[3])) + ((d[0] + d[1]) + (d[2] + d[3]))); }
template <int ACT, int SCALE  > struct EpiAct {
    static constexpr bool PERM = true, AFTER_DRAIN = false, SEG = false;
    bf16_t* O; int ldc; const float* ss;
    const float* qg = nullptr; const float* kg = nullptr; float qscale = 1.f;
    __device__ __forceinline__ void operator()(const f32x4 (&acc)[2][2][4][2], const Unit& u, int wr, int wc, int fr, int fq) const {
        const int row0 = u.pm * BM + wr * 64 + fr, col0 = u.pn * BM + wc * 32 + 8 * fq;
        if (qg != nullptr && u.pn >= 8 && u.pn < 12) {
            const int lane = fq * 16 + fr; const bool isq = u.pn < 10; const float* gp = (isq ? qg : kg) + 8 * fq; const float gsc = isq ? qscale : 1.f;
            float g[2][8];
#pragma unroll
            for (int bj = 0; bj < 2; ++bj) { const f32x4 g0 = *(const f32x4*)(gp + 32 * bj), g1 = *(const f32x4*)(gp + 32 * bj + 4);
                g[bj][0] = g0[0] * gsc; g[bj][1] = g0[1] * gsc; g[bj][2] = g0[2] * gsc; g[bj][3] = g0[3] * gsc; g[bj][4] = g1[0] * gsc; g[bj][5] = g1[1] * gsc; g[bj][6] = g1[2] * gsc; g[bj][7] = g1[3] * gsc; }
#pragma unroll
            for (int ai = 0; ai < 2; ++ai)
#pragma unroll
                for (int m = 0; m < 4; ++m) { const int row = row0 + ai * HALF + m * 16; bf16_t* rowp = O + (size_t)row * ldc + u.pn * BM + wc * 64 + 8 * fq;
                    const float rs = SCALE == 1 ? rstd_of(ss[row]) : SCALE == 2 ? rstd_of(sum16(ss + (size_t)row * 16)) : 1.f;
                    float f[2][8]; float sq = 0.f;
#pragma unroll
                    for (int bj = 0; bj < 2; ++bj) { const f32x4 v0 = acc[ai][bj][m][0], v1 = acc[ai][bj][m][1];
                        f[bj][0] = v0[0] * rs; f[bj][1] = v0[1] * rs; f[bj][2] = v0[2] * rs; f[bj][3] = v0[3] * rs; f[bj][4] = v1[0] * rs; f[bj][5] = v1[1] * rs; f[bj][6] = v1[2] * rs; f[bj][7] = v1[3] * rs;
#pragma unroll
                        for (int j = 0; j < 8; ++j) sq += f[bj][j] * f[bj][j]; }
                    sq += __int_as_float(__builtin_amdgcn_ds_bpermute((lane ^ 16) << 2, __float_as_int(sq)));
                    sq += __int_as_float(__builtin_amdgcn_ds_bpermute((lane ^ 32) << 2, __float_as_int(sq)));
                    const float rq = __builtin_amdgcn_rsqf(sq * (1.0f / 64.0f) + 1e-6f);
#pragma unroll
                    for (int bj = 0; bj < 2; ++bj) {
#pragma unroll
                        for (int j = 0; j < 8; ++j) f[bj][j] = f[bj][j] * rq * g[bj][j];
                        *(u32x4*)(rowp + 32 * bj) = pack8(f[bj]); }
                    asm volatile("" ::: "memory"); }
            return;
        }
#pragma unroll
        for (int ai = 0; ai < 2; ++ai)
#pragma unroll
            for (int m = 0; m < 4; ++m) { const int row = row0 + ai * HALF + m * 16; bf16_t* rowp = O + (size_t)row * ldc + col0;
                const float rs = SCALE == 1 ? rstd_of(ss[row]) : SCALE == 2 ? rstd_of(sum16(ss + (size_t)row * 16)) : 1.f;
#pragma unroll
                for (int bj = 0; bj < 2; ++bj) { const f32x4 v0 = acc[ai][bj][m][0], v1 = acc[ai][bj][m][1];
                    float f[8] = {v0[0], v0[1], v0[2], v0[3], v1[0], v1[1], v1[2], v1[3]};
#pragma unroll
                    for (int j = 0; j < 8; ++j) { if (SCALE) f[j] *= rs; if (ACT == 1) f[j] = sigmoid_f(f[j]); if (ACT == 2) { const float r = fmaxf(f[j], 0.f); f[j] = r * r; } }
                    *(u32x4*)(rowp + bj * HALF) = pack8(f); }
                asm volatile("" ::: "memory"); }
    }
};
template <bool FIRST> struct EpiMerge {
    static constexpr bool PERM = true, AFTER_DRAIN = false, SEG = false;
    const bf16_t* G; int ldg; bf16_t* Mg;
    __device__ __forceinline__ void operator()(const f32x4 (&acc)[2][2][4][2], const Unit& u, int wr, int wc, int fr, int fq) const {
        const int row0 = u.pm * BM + wr * 64 + fr, col0 = u.pn * BM + wc * 32 + 8 * fq;
#pragma unroll
        for (int ai = 0; ai < 2; ++ai)
#pragma unroll
            for (int m = 0; m < 4; ++m) { const size_t row = (size_t)(row0 + ai * HALF + m * 16);
#pragma unroll
                for (int bj = 0; bj < 2; ++bj) { const f32x4 v0 = acc[ai][bj][m][0], v1 = acc[ai][bj][m][1];
                    const float a[8] = {v0[0], v0[1], v0[2], v0[3], v1[0], v1[1], v1[2], v1[3]};
                    float g[8], o[8]; unpack8(*(const u32x4*)(G + row * ldg + col0 + bj * HALF), g);
                    bf16_t* mp = Mg + row * 1024 + col0 + bj * HALF;
                    if (FIRST) {
#pragma unroll
                        for (int j = 0; j < 8; ++j) o[j] = g[j] * a[j];
                    } else { unpack8(*(const u32x4*)mp, o);
#pragma unroll
                        for (int j = 0; j < 8; ++j) o[j] += g[j] * a[j]; }
                    *(u32x4*)mp = pack8(o); asm volatile("" ::: "memory"); } }
    }
};
struct EpiMergeR {
    static constexpr bool PERM = true, AFTER_DRAIN = false, SEG = true;
    const bf16_t* G; bf16_t* Mg;
    __device__ __forceinline__ void seg(f32x4 (&acc)[2][2][4][2], const Unit& u, int wr, int wc, int fr, int fq) const {
        const int row0 = u.pm * BM + wr * 64 + fr, col0 = u.pn * BM + wc * 32 + 8 * fq;
        const bool last = (u.seg == 2);
        const bf16_t* pn = G + u.seg * 1024 + (size_t)row0 * 3072 + col0;
        const int doff = last ? 0 : 1024;
        asm volatile("s_nop 15\n\ts_nop 7" ::: "memory");
#pragma unroll
        for (int ai = 0; ai < 2; ++ai)
#pragma unroll
            for (int m = 0; m < 4; ++m) {
                asm volatile("" : "+v"(pn));
#pragma unroll
                for (int bj = 0; bj < 2; ++bj) {
                    float gn[8], gd[8]; unpack8(*(const u32x4*)(pn + bj * HALF), gn); unpack8(*(const u32x4*)(pn + doff + bj * HALF), gd);
#pragma unroll
                    for (int j = 0; j < 8; ++j) { const float den = last ? 1.f : __builtin_amdgcn_rcpf(fmaxf(gd[j], 1e-20f)); float r = fmaxf(gn[j], 1e-20f) * den;
                        asm volatile("" : "+v"(r));
                        float f = acc[ai][bj][m][j >> 2][j & 3]; asm volatile("v_mul_f32 %0, %0, %1" : "+v"(f) : "v"(r)); acc[ai][bj][m][j >> 2][j & 3] = f; } }
                pn += (m == 3 ? (HALF - 48) : 16) * 3072;
                asm volatile("" ::: "memory"); }
        if (last) {
            bf16_t* po = Mg + (size_t)row0 * 1024 + col0;
#pragma unroll
            for (int ai = 0; ai < 2; ++ai)
#pragma unroll
                for (int m = 0; m < 4; ++m) {
                    asm volatile("" : "+v"(po));
#pragma unroll
                    for (int bj = 0; bj < 2; ++bj) { const f32x4 v0 = acc[ai][bj][m][0], v1 = acc[ai][bj][m][1];
                        const float f[8] = {v0[0], v0[1], v0[2], v0[3], v1[0], v1[1], v1[2], v1[3]};
                        *(u32x4*)(po + bj * HALF) = pack8(f); }
                    po += (m == 3 ? (HALF - 48) : 16) * 1024;
                    asm volatile("" ::: "memory"); }
        }
    }
};
struct EpiResid {
    static constexpr bool PERM = true, AFTER_DRAIN = false, SEG = false;
    const float* base; float* out;
    __device__ __forceinline__ void operator()(const f32x4 (&acc)[2][2][4][2], const Unit& u, int wr, int wc, int fr, int fq) const {
        const int row0 = u.pm * BM + wr * 64 + fr, col0 = u.pn * BM + wc * 32 + 8 * fq;
#pragma unroll
        for (int ai = 0; ai < 2; ++ai)
#pragma unroll
            for (int m = 0; m < 4; ++m) { const size_t off = (size_t)(row0 + ai * HALF + m * 16) * 1024 + col0;
#pragma unroll
                for (int bj = 0; bj < 2; ++bj) { const f32x4 b0 = *(const f32x4*)(base + off + bj * HALF), b1 = *(const f32x4*)(base + off + bj * HALF + 4);
                    *(f32x4*)(out + off + bj * HALF) = b0 + acc[ai][bj][m][0]; *(f32x4*)(out + off + bj * HALF + 4) = b1 + acc[ai][bj][m][1]; }
                if (m & 1) asm volatile("" ::: "memory"); }
    }
};
struct EpiResidN {
    static constexpr bool PERM = true, AFTER_DRAIN = false, SEG = false;
    const float* basef; bf16_t* hb; float* ss;
    __device__ __forceinline__ void operator()(const f32x4 (&acc)[2][2][4][2], const Unit& u, int wr, int wc, int fr, int fq) const {
        const int row0 = u.pm * BM + wr * 64 + fr, col0 = u.pn * BM + wc * 32 + 8 * fq, lane = fq * 16 + fr;
#pragma unroll
        for (int ai = 0; ai < 2; ++ai)
#pragma unroll
            for (int m = 0; m < 4; ++m) { const int row = row0 + ai * HALF + m * 16; const size_t off = (size_t)row * 1024 + col0; float sq = 0.f;
#pragma unroll
                for (int bj = 0; bj < 2; ++bj) { float b[8];
                    if (basef) { const f32x4 b0 = *(const f32x4*)(basef + off + bj * HALF), b1 = *(const f32x4*)(basef + off + bj * HALF + 4);
                        b[0] = b0[0]; b[1] = b0[1]; b[2] = b0[2]; b[3] = b0[3]; b[4] = b1[0]; b[5] = b1[1]; b[6] = b1[2]; b[7] = b1[3]; }
                    else unpack8(*(const u32x4*)(hb + off + bj * HALF), b);
                    const f32x4 a0 = acc[ai][bj][m][0], a1 = acc[ai][bj][m][1];
                    const float f[8] = {b[0] + a0[0], b[1] + a0[1], b[2] + a0[2], b[3] + a0[3], b[4] + a1[0], b[5] + a1[1], b[6] + a1[2], b[7] + a1[3]};
#pragma unroll
                    for (int j = 0; j < 8; ++j) sq += f[j] * f[j];
                    *(u32x4*)(hb + off + bj * HALF) = pack8(f); }
                sq += __int_as_float(__builtin_amdgcn_ds_bpermute((lane ^ 16) << 2, __float_as_int(sq)));
                sq += __int_as_float(__builtin_amdgcn_ds_bpermute((lane ^ 32) << 2, __float_as_int(sq)));
                if (fq == 0) ss[(size_t)row * 16 + u.pn * 4 + wc] = sq;
                if (m & 1) asm volatile("" ::: "memory"); }
    }
};
struct EpiPle {
    static constexpr bool PERM = true, AFTER_DRAIN = false, SEG = false;
    const bf16_t* baseb; float* out; bf16_t* PP; const float* ss; float* ssout;
    __device__ __forceinline__ void operator()(const f32x4 (&acc)[2][2][4][2], const Unit& u, int wr, int wc, int fr, int fq) const {
        const int row0 = u.pm * BM + wr * 64 + fr, col0 = u.pn * BM + wc * 32 + 8 * fq, lane = fq * 16 + fr;
#pragma unroll
        for (int ai = 0; ai < 2; ++ai)
#pragma unroll
            for (int m = 0; m < 4; ++m) { const int row = row0 + ai * HALF + m * 16; const size_t off = (size_t)row * 1024 + col0; const float rs = rstd_of(sum16(ss + (size_t)row * 16)); float sq = 0.f;
#pragma unroll
                for (int bj = 0; bj < 2; ++bj) { float bb[8], pp[8]; unpack8(*(const u32x4*)(baseb + off + bj * HALF), bb); unpack8(*(const u32x4*)(PP + off + bj * HALF), pp);
                    const f32x4 v0 = acc[ai][bj][m][0], v1 = acc[ai][bj][m][1];
                    float f[8];
#pragma unroll
                    for (int j = 0; j < 4; ++j) { f[j] = bb[j] + sigmoid_f(v0[j] * rs) * pp[j]; f[4 + j] = bb[4 + j] + sigmoid_f(v1[j] * rs) * pp[4 + j]; }
                    if (out) { *(f32x4*)(out + off + bj * HALF) = (f32x4){f[0], f[1], f[2], f[3]}; *(f32x4*)(out + off + bj * HALF + 4) = (f32x4){f[4], f[5], f[6], f[7]}; }
                    else {
#pragma unroll
                        for (int j = 0; j < 8; ++j) sq += f[j] * f[j];
                        *(u32x4*)(PP + off + bj * HALF) = pack8(f); } }
                if (!out) { sq += __int_as_float(__builtin_amdgcn_ds_bpermute((lane ^ 16) << 2, __float_as_int(sq)));
                            sq += __int_as_float(__builtin_amdgcn_ds_bpermute((lane ^ 32) << 2, __float_as_int(sq)));
                            if (fq == 0) ssout[(size_t)row * 16 + u.pn * 4 + wc] = sq; }
                if (m & 1) asm volatile("" ::: "memory"); }
    }
};

template <class Epi, class Sched, bool ALIGN_EPI = false, bool SP2 = false>
__device__ __forceinline__ void gemm_phase(PG8_LAS unsigned char* lds, const Gemm g, const Sched& S, const Epi& E, const int tid_in) {
    int tid = tid_in; asm volatile("" : "+v"(tid));
    const int wid = __builtin_amdgcn_readfirstlane(tid >> 6), lane = tid & 63, wr = wid >> 2, wc = wid & 3, fr = lane & 15, fq = lane >> 4;
    int Kq = g.K; asm volatile("" : "+s"(Kq)); const int nt = Kq / BK;
    unsigned voffA[2], voffB[2];
#pragma unroll
    for (int i = 0; i < 2; ++i) { int R, C; stage_rc(tid * 16 + i * 8192, R, C); const int Rb = Epi::PERM ? ((R & ~31) + perm32(R & 31)) : R;
        voffA[i] = (unsigned)(R * g.lda + C) * 2u; voffB[i] = (unsigned)(Rb * g.ldb + C) * 2u; }
    const size_t kstep = (size_t)(BK * 2);
    const size_t hstepA = (size_t)HALF * g.lda * 2, hstepB = (size_t)HALF * g.ldb * 2;
    const size_t tstepA = 2 * hstepA, tstepB = 2 * hstepB;
    const unsigned ldsw = (unsigned)wid * 1024u;
    const int aoff = lds_byte(wr * 64 + fr, fq * 8), boff = lds_byte(wc * 32 + fr, fq * 8);
#define PG8_SA(b, h) (((b) * 2 + (h)) * HTB)
#define PG8_SB(b, h) ((4 + (b) * 2 + (h)) * HTB)
#define PG8_STAGE(bufoff, gbase, voff) do { _Pragma("unroll") for (int _i = 0; _i < 2; ++_i) \
        __builtin_amdgcn_global_load_lds((const unsigned*)((const char*)(gbase) + (voff)[_i]), (PG8_LAS unsigned*)(lds + (bufoff) + ldsw + _i * 8192), 16, 0, 0); } while (0)
#define PG8_LDA(dst, b, h) do { _Pragma("unroll") for (int m = 0; m < 4; ++m) _Pragma("unroll") for (int k = 0; k < 2; ++k) dst[m][k] = *(const PG8_LAS bf16x8*)(lds + PG8_SA(b, h) + aoff + m * 2048 + k * 1024); } while (0)
#define PG8_LDB(dst, b, h) do { _Pragma("unroll") for (int n = 0; n < 2; ++n) _Pragma("unroll") for (int k = 0; k < 2; ++k) dst[n][k] = *(const PG8_LAS bf16x8*)(lds + PG8_SB(b, h) + boff + n * 2048 + k * 1024); } while (0)
#define PG8_MMA(ai, bj, At, Bt) do { __builtin_amdgcn_s_setprio(1); _Pragma("unroll") for (int m = 0; m < 4; ++m) _Pragma("unroll") for (int n = 0; n < 2; ++n) _Pragma("unroll") for (int k = 0; k < 2; ++k) \
        acc[ai][bj][m][n] = __builtin_amdgcn_mfma_f32_16x16x32_bf16(Bt[n][k], At[m][k], acc[ai][bj][m][n], 0, 0, 0); __builtin_amdgcn_s_setprio(0); } while (0)
#define PG8_WAIT_V(n) asm volatile("s_waitcnt vmcnt(" #n ")" ::: "memory")
#define PG8_WAIT_L(n) asm volatile("s_waitcnt lgkmcnt(" #n ")" ::: "memory")
#define PG8_BAR __builtin_amdgcn_s_barrier()
#define PG8_SCHED __builtin_amdgcn_sched_barrier(0)
    Unit cur, nxt; int ui = 0;
    if (!S.next(0, cur)) return;
    f32x4 acc[2][2][4][2];
#pragma unroll
    for (int a = 0; a < 2; ++a)
#pragma unroll
        for (int b = 0; b < 2; ++b)
#pragma unroll
            for (int m = 0; m < 4; ++m)
#pragma unroll
                for (int n = 0; n < 2; ++n) acc[a][b][m][n] = (f32x4){0.f, 0.f, 0.f, 0.f};
    bf16x8 At[4][2], B0[2][2], B1[2][2];
    const char* cA = (const char*)g.A + (size_t)cur.pm * tstepA + (size_t)cur.seg * g.segA; const char* cB = (const char*)g.Bt + (size_t)cur.pn * tstepB + (size_t)cur.seg * g.segB;
    S.a_ready(cur);
    if constexpr (SP2) {
        PG8_STAGE(PG8_SB(0, 0), cB, voffB); PG8_STAGE(PG8_SB(0, 1), cB + hstepB, voffB); PG8_STAGE(PG8_SA(0, 0), cA, voffA); PG8_STAGE(PG8_SA(0, 1), cA + hstepA, voffA);
        if (wr == 1) PG8_BAR;
        PG8_WAIT_V(2); PG8_BAR;
        PG8_STAGE(PG8_SB(1, 0), cB + kstep, voffB); PG8_STAGE(PG8_SA(1, 0), cA + kstep, voffA); PG8_STAGE(PG8_SB(1, 1), cB + hstepB + kstep, voffB);
        PG8_WAIT_V(6); PG8_BAR;
    } else {
        PG8_STAGE(PG8_SB(0, 0), cB, voffB); PG8_STAGE(PG8_SA(0, 0), cA, voffA); PG8_STAGE(PG8_SB(0, 1), cB + hstepB, voffB); PG8_STAGE(PG8_SA(0, 1), cA + hstepA, voffA);
        if (wr == 1) PG8_BAR;
        PG8_WAIT_V(4); PG8_BAR;
        PG8_STAGE(PG8_SB(1, 0), cB + kstep, voffB); PG8_STAGE(PG8_SA(1, 0), cA + kstep, voffA); PG8_STAGE(PG8_SB(1, 1), cB + hstepB + kstep, voffB);
        PG8_WAIT_V(6); PG8_BAR;
    }
    for (;;) {
        const bool has_next = S.next(ui + 1, nxt);
        const char* nA = has_next ? (const char*)g.A + (size_t)nxt.pm * tstepA + (size_t)nxt.seg * g.segA : cA; const char* nB = has_next ? (const char*)g.Bt + (size_t)nxt.pn * tstepB + (size_t)nxt.seg * g.segB : cB;
        for (int t = 0; t < nt; t += 2) {
            const bool last = (t == nt - 2);
            const char* a1 = cA + (size_t)(t + 1) * kstep;
            const char* a2 = last ? nA : cA + (size_t)(t + 2) * kstep; const char* b2 = last ? nB : cB + (size_t)(t + 2) * kstep;
            const char* a3 = a2 + kstep; const char* b3 = b2 + kstep;
            if (last && has_next) S.a_ready(nxt);
            if constexpr (SP2) {
            PG8_LDB(B0, 0, 0); PG8_LDB(B1, 0, 1); PG8_SCHED; PG8_LDA(At, 0, 0); PG8_STAGE(PG8_SA(1, 1), a1 + hstepA, voffA);
            PG8_WAIT_V(8); PG8_WAIT_L(0); PG8_BAR; PG8_MMA(0, 0, At, B0); PG8_MMA(0, 1, At, B1); PG8_BAR; PG8_SCHED;
            PG8_LDA(At, 0, 1); PG8_STAGE(PG8_SB(0, 0), b2, voffB); PG8_STAGE(PG8_SB(0, 1), b2 + hstepB, voffB); PG8_STAGE(PG8_SA(0, 0), a2, voffA);
            PG8_WAIT_V(8); PG8_WAIT_L(0); PG8_BAR; PG8_MMA(1, 0, At, B0); PG8_MMA(1, 1, At, B1); PG8_BAR; PG8_SCHED;
            PG8_LDB(B0, 1, 0); PG8_LDB(B1, 1, 1); PG8_SCHED; PG8_LDA(At, 1, 0); PG8_STAGE(PG8_SA(0, 1), a2 + hstepA, voffA);
            PG8_WAIT_V(8); PG8_WAIT_L(0); PG8_BAR; PG8_MMA(0, 0, At, B0); PG8_MMA(0, 1, At, B1); PG8_BAR; PG8_SCHED;
            PG8_LDA(At, 1, 1); PG8_STAGE(PG8_SB(1, 0), b3, voffB); PG8_STAGE(PG8_SB(1, 1), b3 + hstepB, voffB); PG8_STAGE(PG8_SA(1, 0), a3, voffA);
            PG8_WAIT_V(8); PG8_WAIT_L(0); PG8_BAR; PG8_MMA(1, 0, At, B0); PG8_MMA(1, 1, At, B1); PG8_BAR; PG8_SCHED;
            } else {
            PG8_LDB(B0, 0, 0); PG8_SCHED; PG8_LDA(At, 0, 0); PG8_STAGE(PG8_SA(1, 1), a1 + hstepA, voffA);
            PG8_WAIT_L(8); PG8_BAR; PG8_WAIT_L(0); PG8_MMA(0, 0, At, B0); PG8_BAR; PG8_SCHED;
            PG8_LDB(B1, 0, 1); PG8_STAGE(PG8_SB(0, 0), b2, voffB);
            PG8_BAR; PG8_WAIT_L(0); PG8_MMA(0, 1, At, B1); PG8_BAR;
            PG8_LDA(At, 0, 1); PG8_STAGE(PG8_SA(0, 0), a2, voffA);
            PG8_BAR; PG8_WAIT_L(0); PG8_MMA(1, 0, At, B0); PG8_BAR; PG8_SCHED;
            PG8_STAGE(PG8_SB(0, 1), b2 + hstepB, voffB);
            PG8_WAIT_V(6); PG8_BAR; PG8_MMA(1, 1, At, B1); PG8_BAR;
            PG8_LDB(B0, 1, 0); PG8_SCHED; PG8_LDA(At, 1, 0); PG8_STAGE(PG8_SA(0, 1), a2 + hstepA, voffA);
            PG8_WAIT_L(8); PG8_BAR; PG8_WAIT_L(0); PG8_MMA(0, 0, At, B0); PG8_BAR; PG8_SCHED;
            PG8_LDB(B1, 1, 1); PG8_STAGE(PG8_SB(1, 0), b3, voffB);
            PG8_BAR; PG8_WAIT_L(0); PG8_MMA(0, 1, At, B1); PG8_BAR;
            PG8_LDA(At, 1, 1); PG8_STAGE(PG8_SA(1, 0), a3, voffA);
            PG8_BAR; PG8_WAIT_L(0); PG8_MMA(1, 0, At, B0); PG8_BAR; PG8_SCHED;
            PG8_STAGE(PG8_SB(1, 1), b3 + hstepB, voffB);
            PG8_WAIT_V(6); PG8_BAR; PG8_MMA(1, 1, At, B1); PG8_BAR;
            }
        }
        if constexpr (ALIGN_EPI) { if (wr == 0) PG8_BAR; }
        if constexpr (Epi::SEG) { E.seg(acc, cur, wr, wc, fr, fq); } else if constexpr (!Epi::AFTER_DRAIN) { E(acc, cur, wr, wc, fr, fq); S.done(cur); }
        if (!has_next) break;
        if constexpr (Epi::SEG) {
            const float keep = (cur.seg != 2) ? 1.f : 0.f;
#pragma unroll
            for (int a = 0; a < 2; ++a)
#pragma unroll
                for (int b = 0; b < 2; ++b)
#pragma unroll
                    for (int m = 0; m < 4; ++m)
#pragma unroll
                        for (int n = 0; n < 2; ++n)
#pragma unroll
                            for (int j = 0; j < 4; ++j) { float f = acc[a][b][m][n][j]; asm volatile("v_mul_f32 %0, %0, %1" : "+v"(f) : "s"(keep)); acc[a][b][m][n][j] = f; }
        } else {
#pragma unroll
            for (int a = 0; a < 2; ++a)
#pragma unroll
                for (int b = 0; b < 2; ++b)
#pragma unroll
                    for (int m = 0; m < 4; ++m)
#pragma unroll
                        for (int n = 0; n < 2; ++n) acc[a][b][m][n] = (f32x4){0.f, 0.f, 0.f, 0.f};
        }
        cur = nxt; cA = nA; cB = nB; ++ui;
        if constexpr (ALIGN_EPI) { if (wr == 1) PG8_BAR; }
    }
    PG8_WAIT_V(0);
    if constexpr (!ALIGN_EPI) { if (wr == 0) PG8_BAR; }
    PG8_BAR;
    if constexpr (Epi::AFTER_DRAIN) { E.fused(acc, cur, wr, wc, fr, fq, lds, wid, lane); S.done(cur); }
#undef PG8_SA
#undef PG8_SB
#undef PG8_STAGE
#undef PG8_LDA
#undef PG8_LDB
#undef PG8_MMA
#undef PG8_WAIT_V
#undef PG8_WAIT_L
#undef PG8_BAR
#undef PG8_SCHED
}
}

#include <hip/hip_bf16.h>
#include <cmath>
namespace attn_body {
using bf16=__hip_bfloat16;
using bf16x8=__attribute__((ext_vector_type(8)))short;
using s16x4=__attribute__((ext_vector_type(4)))short;
using f32x16=__attribute__((ext_vector_type(16)))float;
using u32x4=__attribute__((ext_vector_type(4)))unsigned;
constexpr int BATCH=4,NVH=16,SEQ=8192,D=64,PQ=3584,PO=1024,PY=1536;
constexpr int NW=8,QBLK=32,QB=QBLK*NW,KVBLK=64,NQB=SEQ/QB;
constexpr int ATTN_UNIT_ROWS=QB;
__device__ __forceinline__ int crow(int r,int hi){return (r&3)+8*(r>>2)+4*hi;}
#define SBAR() __builtin_amdgcn_sched_barrier(0)
__device__ __forceinline__ void cmask(f32x16&p0,f32x16&p1,int jb,int wid){
  const float NEG=-INFINITY;
  if(jb>(wid>>1)){
  #pragma unroll
  for(int r=0;r<16;++r){p0[r]=NEG;p1[r]=NEG;}}
}

constexpr int NSLOT=3, SLOTB=8192, VSLOTB=2*SLOTB;
constexpr int LDS_K=0, LDS_V=NSLOT*SLOTB, LDS_WS=LDS_V+NSLOT*VSLOTB, LDS_OST=LDS_WS+NW*64*4, LDS_BYTES=LDS_OST+NW*4096;
constexpr float C2=0.125f*1.4426950408889634f;
__device__ __forceinline__ void glds16(const void*gsrc,unsigned lds_dst){unsigned keep;
  asm volatile("s_mov_b32 %0, m0\n\ts_mov_b32 m0, %2\n\ts_nop 0\n\tglobal_load_lds_dwordx4 %1, off\n\ts_mov_b32 m0, %0":"=&s"(keep):"v"(gsrc),"s"(lds_dst):"memory");}
__device__ __forceinline__ float max3f(float a,float b,float c){float r;asm("v_max3_f32 %0, %1, %2, %3":"=v"(r):"v"(a),"v"(b),"v"(c));return r;}
__device__ __forceinline__ float max2f(float a,float b){float r;asm("v_max_f32_e32 %0, %1, %2":"=v"(r):"v"(a),"v"(b));return r;}
__device__ __forceinline__ float fadd_s(float a,float b){float r;asm("v_add_f32_e32 %0, %1, %2":"=v"(r):"v"(a),"v"(b));return r;}
__device__ __forceinline__ float fsub_s(float a,float b){float r;asm("v_sub_f32_e32 %0, %1, %2":"=v"(r):"v"(a),"v"(b));return r;}
typedef float f32x2_t __attribute__((ext_vector_type(2))); typedef __bf16 bf16x2_t __attribute__((ext_vector_type(2)));
__device__ __forceinline__ unsigned cvtpk_s(float lo,float hi){f32x2_t v={lo,hi};bf16x2_t b=__builtin_convertvector(v,bf16x2_t);return __builtin_bit_cast(unsigned,b);}
#define WAIT_BAR(N) asm volatile("s_waitcnt vmcnt(" #N ") lgkmcnt(0)\n\ts_barrier":::"memory")

__device__ __forceinline__ void qkt(f32x16&p0,f32x16&p1,const char*Kslot,const bf16x8*qr,const f32x16&negm,int r32,int hi){
  const char*kb=Kslot+hi*1024+r32*16;
  #pragma unroll
  for(int d0=0;d0<4;++d0){
    const bf16x8 b0=*reinterpret_cast<const bf16x8*>(kb+d0*2048);
    const bf16x8 b1=*reinterpret_cast<const bf16x8*>(kb+d0*2048+512);
    if(d0==0){p0=__builtin_amdgcn_mfma_f32_32x32x16_bf16(b0,qr[0],negm,0,0,0);p1=__builtin_amdgcn_mfma_f32_32x32x16_bf16(b1,qr[0],negm,0,0,0);}
    else{p0=__builtin_amdgcn_mfma_f32_32x32x16_bf16(b0,qr[d0],p0,0,0,0);p1=__builtin_amdgcn_mfma_f32_32x32x16_bf16(b1,qr[d0],p1,0,0,0);}}
}
typedef __attribute__((address_space(3))) const char* lds_cptr;
typedef short v4i16_t __attribute__((ext_vector_type(4)));
__device__ __forceinline__ void kload8(bf16x8*kf,lds_cptr kp){
  kf[0]=*(const __attribute__((address_space(3))) bf16x8*)(kp);      kf[1]=*(const __attribute__((address_space(3))) bf16x8*)(kp+512);
  kf[2]=*(const __attribute__((address_space(3))) bf16x8*)(kp+2048); kf[3]=*(const __attribute__((address_space(3))) bf16x8*)(kp+2560);
  kf[4]=*(const __attribute__((address_space(3))) bf16x8*)(kp+4096); kf[5]=*(const __attribute__((address_space(3))) bf16x8*)(kp+4608);
  kf[6]=*(const __attribute__((address_space(3))) bf16x8*)(kp+6144); kf[7]=*(const __attribute__((address_space(3))) bf16x8*)(kp+6656);
}
__device__ __forceinline__ void kload2(bf16x8*kf,lds_cptr kp,int j){ kf[2*j]=*(const __attribute__((address_space(3))) bf16x8*)(kp+j*2048); kf[2*j+1]=*(const __attribute__((address_space(3))) bf16x8*)(kp+j*2048+512); }
__device__ __forceinline__ s16x4 vtr(lds_cptr p){ return __builtin_bit_cast(s16x4,__builtin_amdgcn_ds_read_tr16_b64_v4i16((__attribute__((address_space(3))) v4i16_t*)p)); }
__device__ __forceinline__ float rowmax(const f32x16&p0,const f32x16&p1){
  float a=max3f(p0[0],p0[1],p1[0]),b=max3f(p0[2],p0[3],p1[1]);a=max3f(a,p1[2],p1[3]);
  #pragma unroll
  for(int r=4;r<16;r+=4){a=max3f(a,p0[r],p0[r+1]);b=max3f(b,p0[r+2],p0[r+3]);a=max3f(a,p1[r],p1[r+1]);b=max3f(b,p1[r+2],p1[r+3]);}
  const float m=max2f(a,b);
  auto rr=__builtin_amdgcn_permlane32_swap(__float_as_uint(m),__float_as_uint(m),false,false);
  return max2f(__uint_as_float(rr[0]),__uint_as_float(rr[1]));
}
__device__ __forceinline__ void pv(f32x16*o,int vb,bf16x8 pa0,bf16x8 pa1,bf16x8 pa2,bf16x8 pa3){
  #pragma unroll
  for(int d0=0;d0<4;++d0){s16x4 lo[4],hi[4];
    #pragma unroll
    for(int ks=0;ks<4;++ks){
      asm volatile("ds_read_b64_tr_b16 %0,%1 offset:%c2":"=&v"(lo[ks]):"v"(vb),"i"(d0*4096+ks*1024):"memory");
      asm volatile("ds_read_b64_tr_b16 %0,%1 offset:%c2":"=&v"(hi[ks]):"v"(vb),"i"(d0*4096+ks*1024+512):"memory");}
    asm volatile("s_waitcnt lgkmcnt(0)":::"memory");SBAR();
    #define PK(k) (bf16x8){lo[k][0],lo[k][1],lo[k][2],lo[k][3],hi[k][0],hi[k][1],hi[k][2],hi[k][3]}
    o[d0]=__builtin_amdgcn_mfma_f32_32x32x16_bf16(pa0,PK(0),o[d0],0,0,0);
    o[d0]=__builtin_amdgcn_mfma_f32_32x32x16_bf16(pa1,PK(1),o[d0],0,0,0);
    o[d0]=__builtin_amdgcn_mfma_f32_32x32x16_bf16(pa2,PK(2),o[d0],0,0,0);
    o[d0]=__builtin_amdgcn_mfma_f32_32x32x16_bf16(pa3,PK(3),o[d0],0,0,0);
    #undef PK
  }
}

#ifndef ATTN_STORE16
#define ATTN_STORE16(p,v) (*(u32x4*)(p)=(v))
#endif
template<int THRL> __device__ __forceinline__ void attn_unit(int b,int qb,const bf16*Q,const bf16*__restrict__ K,const bf16*__restrict__ V,bf16*O,char*shm,const int tid,const int half,const float lam,const float post,const float*subg,bf16*Yc,const bool hasn,const long dK,const long dV,const bool pre){
  const int lane=tid&63,r32=lane&31,hi=lane>>5; const int wid=__builtin_amdgcn_readfirstlane(tid>>6);
  const long rowbase=(long)b*SEQ; const int q0=qb*QB;
  const bf16*Qw=Q+(rowbase+q0+wid*QBLK)*PQ;
  const bf16*Kh=K+rowbase*PQ,*Vh=V+rowbase*PQ;
  const unsigned lds0=(unsigned)(uintptr_t)shm;
  float*wsf=(float*)(shm+LDS_WS)+wid*64;
  const bf16*ksrc=Kh+(long)lane*PQ+wid*8;
  const bf16*vsrc=Vh+(long)(16*(wid&3)+(lane>>2))*PQ+(wid>>2)*32+(lane&3)*8;
  const unsigned kdst=lds0+LDS_K+wid*1024, vdst=lds0+LDS_V+wid*1024;
  #define DMA_K(t,slot) glds16(ksrc+(long)(t)*KVBLK*PQ,(unsigned)__builtin_amdgcn_readfirstlane(kdst+(slot)))
  #define DMA_V(t,slot) do{ glds16(vsrc+(long)(t)*KVBLK*PQ,(unsigned)__builtin_amdgcn_readfirstlane(vdst+2*(slot))); glds16(vsrc+(long)(t)*KVBLK*PQ+64,(unsigned)__builtin_amdgcn_readfirstlane(vdst+2*(slot)+8192)); }while(0)
  const char*Kbase=shm+LDS_K; bf16x8 kf[8];
  const lds_cptr shm3=(lds_cptr)shm; const lds_cptr kp0=shm3+LDS_K+hi*1024+r32*16; const lds_cptr vp0=shm3+LDS_V+((lane>>4)&1)*32+(lane&3)*8+(4*hi+((lane&15)>>2))*64;
  const int NT=(q0+QB)/KVBLK;
  if(!pre){DMA_K(0,0);DMA_V(0,0);DMA_K(1,SLOTB);}
  bf16x8 qr[4];
  #pragma unroll
  for(int d0=0;d0<4;++d0)qr[d0]=*reinterpret_cast<const bf16x8*>(&Qw[(long)r32*PQ+d0*16+hi*8]);
  float l_reg=0.f;f32x16 o[4];o[0]=f32x16{};o[1]=f32x16{};o[2]=f32x16{};o[3]=f32x16{};const f32x16 zero16=f32x16{};
  #define CMASK(P0,P1,t) do{int jb_=(t)-(NT-4); if(jb_>=0)cmask(P0,P1,jb_,wid);}while(0)
  f32x16 pA0,pA1,pB0,pB1;
  int sl_prev=0,sl_cur=0,sl_next=SLOTB;
  #define ROT() do{sl_prev=sl_cur;sl_cur=sl_next;sl_next=(sl_next==(NSLOT-1)*SLOTB)?0:sl_next+SLOTB;}while(0)
  DMA_K(2,2*SLOTB);
  WAIT_BAR(4);
  qkt(pA0,pA1,Kbase,qr,zero16,r32,hi);asm volatile("s_nop 15\n\ts_nop 7":"+v"(pA0),"+v"(pA1));CMASK(pA0,pA1,0);
  _Pragma("unroll") for(int r=0;r<16;++r)pA0[r]=__builtin_amdgcn_exp2f(pA0[r]);
  _Pragma("unroll") for(int r=0;r<16;++r)pA1[r]=__builtin_amdgcn_exp2f(pA1[r]);
  WAIT_BAR(0);
  DMA_K(3,0);DMA_V(1,SLOTB);
  ROT();
  kload8(kf,kp0+sl_cur);
  WAIT_BAR(3);
  s16x4 vlo[8],vhi[8],wlo[8],whi[8]; u32x4 pw0,pw1,pw2,pw3;
  #define PKW(P,B) cvtpk_s(P[B],P[B+1])
  #define PAF(k) __builtin_bit_cast(bf16x8,pw##k)
  #define VFR(i) (bf16x8){vlo[i][0],vlo[i][1],vlo[i][2],vlo[i][3],vhi[i][0],vhi[i][1],vhi[i][2],vhi[i][3]}
  #define WFR(i) (bf16x8){wlo[i][0],wlo[i][1],wlo[i][2],wlo[i][3],whi[i][0],whi[i][1],whi[i][2],whi[i][3]}
  #define PIN(x) asm volatile("":"+v"(x))
  #define GAPA(MF,A0,A1,A2,A3,W0,W1,PW) do{ MF; sacc+=A0; sacc+=A1; sacc+=A2; sacc+=A3; PIN(sacc); W0; W1; PIN(PW); SBAR(); }while(0)
  #define EX(v) __builtin_amdgcn_exp2f(v)
  #define GAPB(MF,X,B) do{ MF; X[B]=EX(X[B]); X[B+1]=EX(X[B+1]); PIN(X); SBAR(); }while(0)
  #define VRD(i) do{ vlo[i]=vtr(vp_+(((i)>>2)*4096+((i)&3)*1024)); vhi[i]=vtr(vp_+(((i)>>2)*4096+((i)&3)*1024+512)); }while(0)
  #define WRD(i) do{ wlo[i]=vtr(vp_+(8192+((i)>>2)*4096+((i)&3)*1024)); whi[i]=vtr(vp_+(8192+((i)>>2)*4096+((i)&3)*1024+512)); SBAR(); }while(0)
  #define KRD(G,j) do{ if(G){ kload2(kf,kp0+sl_next,j); SBAR(); } }while(0)
  #define MF32(a,b,c) __builtin_amdgcn_mfma_f32_32x32x16_bf16(a,b,c,0,0,0)
  #define STEP(C0,C1,P0,P1,t,GK,GV,GL) do{ SBAR(); \
    const lds_cptr vp_=vp0+2*sl_prev; \
    VRD(0); SBAR(); float sacc=(P0[0]+P0[1]); \
    GAPA(C0=MF32(kf[0],qr[0],zero16), P0[2],P0[3],P0[4],P0[5],     pw0[0]=PKW(P0,0), pw0[1]=PKW(P0,2), pw0); \
    VRD(4); SBAR(); GAPA(C1=MF32(kf[1],qr[0],zero16), P0[6],P0[7],P0[8],P0[9],     pw0[2]=PKW(P0,4), pw0[3]=PKW(P0,6), pw0); \
    VRD(1); SBAR(); GAPA(C0=MF32(kf[2],qr[1],C0),   P0[10],P0[11],P0[12],P0[13], pw1[0]=PKW(P0,8), pw1[1]=PKW(P0,10), pw1); \
    VRD(5); SBAR(); GAPA(C1=MF32(kf[3],qr[1],C1),   P0[14],P0[15],P1[0],P1[1],   pw1[2]=PKW(P0,12),pw1[3]=PKW(P0,14), pw1); \
    VRD(2); SBAR(); GAPA(C0=MF32(kf[4],qr[2],C0),   P1[2],P1[3],P1[4],P1[5],     pw2[0]=PKW(P1,0), pw2[1]=PKW(P1,2), pw2); \
    VRD(6); SBAR(); GAPA(C1=MF32(kf[5],qr[2],C1),   P1[6],P1[7],P1[8],P1[9],     pw2[2]=PKW(P1,4), pw2[3]=PKW(P1,6), pw2); \
    VRD(3); SBAR(); GAPA(C0=MF32(kf[6],qr[3],C0),   P1[10],P1[11],P1[12],P1[13], pw3[0]=PKW(P1,8), pw3[1]=PKW(P1,10), pw3); \
    VRD(7); SBAR(); GAPA(C1=MF32(kf[7],qr[3],C1),   P1[14],P1[15],0.f,0.f,       pw3[2]=PKW(P1,12),pw3[3]=PKW(P1,14), pw3); \
    l_reg+=sacc; \
    if(GK){DMA_K((t)+3,sl_cur);} if(GV){DMA_V((t)+1,sl_next);} \
    CMASK(C0,C1,t); \
    SBAR(); \
    GAPB(o[0]=MF32(PAF(0),VFR(0),o[0]), C0,0);  WRD(0); \
    GAPB(o[1]=MF32(PAF(0),VFR(4),o[1]), C0,2);  WRD(4); \
    GAPB(o[0]=MF32(PAF(1),VFR(1),o[0]), C0,4);  WRD(1); \
    GAPB(o[1]=MF32(PAF(1),VFR(5),o[1]), C0,6);  WRD(5); \
    GAPB(o[0]=MF32(PAF(2),VFR(2),o[0]), C0,8);  WRD(2); \
    GAPB(o[1]=MF32(PAF(2),VFR(6),o[1]), C0,10); WRD(6); \
    GAPB(o[0]=MF32(PAF(3),VFR(3),o[0]), C0,12); WRD(3); \
    GAPB(o[1]=MF32(PAF(3),VFR(7),o[1]), C0,14); WRD(7); \
    GAPB(o[2]=MF32(PAF(0),WFR(0),o[2]), C1,0); \
    GAPB(o[3]=MF32(PAF(0),WFR(4),o[3]), C1,2); \
    KRD(GL,0); GAPB(o[2]=MF32(PAF(1),WFR(1),o[2]), C1,4); \
    KRD(GL,1); GAPB(o[3]=MF32(PAF(1),WFR(5),o[3]), C1,6); \
    KRD(GL,2); GAPB(o[2]=MF32(PAF(2),WFR(2),o[2]), C1,8); \
    KRD(GL,3); GAPB(o[3]=MF32(PAF(2),WFR(6),o[3]), C1,10); \
    GAPB(o[2]=MF32(PAF(3),WFR(3),o[2]), C1,12); \
    GAPB(o[3]=MF32(PAF(3),WFR(7),o[3]), C1,14); \
    }while(0)
  int t=1;
  #undef CMASK
  #define CMASK(P0,P1,t) do{}while(0)
  for(;t+5<NT;t+=2){
    STEP(pB0,pB1,pA0,pA1,t,true,true,true);     WAIT_BAR(3); ROT();
    STEP(pA0,pA1,pB0,pB1,t+1,true,true,true);   WAIT_BAR(3); ROT();
  }
  #undef CMASK
  #define CMASK(P0,P1,t) do{int jb_=(t)-(NT-4); if(jb_>=0)cmask(P0,P1,jb_,wid);}while(0)
  #define ENDW(tt) do{ if((tt)+3<NT){WAIT_BAR(3);} else if((tt)+2<NT){WAIT_BAR(2);} else {WAIT_BAR(0);} }while(0)
  for(;t+1<NT;t+=2){
    STEP(pB0,pB1,pA0,pA1,t,(t+3<NT),(t+1<NT),(t+1<NT));       ENDW(t);   ROT();
    STEP(pA0,pA1,pB0,pB1,t+1,(t+4<NT),(t+2<NT),(t+2<NT));     ENDW(t+1); ROT();
  }
  STEP(pB0,pB1,pA0,pA1,NT-1,false,false,false);
  { float sacc=pB0[0]+pB0[1]; _Pragma("unroll") for(int r=2;r<16;++r)sacc+=pB0[r]; _Pragma("unroll") for(int r=0;r<16;++r)sacc+=pB1[r]; l_reg+=sacc;
    pw0=(u32x4){PKW(pB0,0),PKW(pB0,2),PKW(pB0,4),PKW(pB0,6)};pw1=(u32x4){PKW(pB0,8),PKW(pB0,10),PKW(pB0,12),PKW(pB0,14)};pw2=(u32x4){PKW(pB1,0),PKW(pB1,2),PKW(pB1,4),PKW(pB1,6)};pw3=(u32x4){PKW(pB1,8),PKW(pB1,10),PKW(pB1,12),PKW(pB1,14)};
    SBAR(); pv(o,(int)(unsigned)(uintptr_t)vp0+2*sl_cur,PAF(0),PAF(1),PAF(2),PAF(3)); }
  asm volatile("s_waitcnt lgkmcnt(0)\n\ts_barrier":::"memory");
  #define PREF_NEXT() do{ if(hasn){   \
      const bf16*nks=K+dK+(rowbase+lane_e)*PQ+wid*8; const bf16*nvs=V+dV+(rowbase+16*(wid&3)+(lane_e>>2))*PQ+(wid>>2)*32+(lane_e&3)*8; \
      glds16(nks,(unsigned)__builtin_amdgcn_readfirstlane(kdst)); glds16(nvs,(unsigned)__builtin_amdgcn_readfirstlane(vdst)); glds16(nvs+64,(unsigned)__builtin_amdgcn_readfirstlane(vdst+8192)); \
      glds16(nks+(long)KVBLK*PQ,(unsigned)__builtin_amdgcn_readfirstlane(kdst+SLOTB)); } }while(0)
  #undef PKW
  #undef PAF
  #undef VFR
  #undef WFR
  #undef PIN
  #undef GAPA
  #undef GAPB
  #undef EX
  #undef VRD
  #undef WRD
  #undef KRD
  #undef MF32
  #undef STEP
  #undef ENDW
  int tide=tid; asm volatile("":"+v"(tide)); const int lane_e=tide&63,r32e=lane_e&31,hie=lane_e>>5;
  {auto rr=__builtin_amdgcn_permlane32_swap(__float_as_uint(l_reg),__float_as_uint(l_reg),false,false);l_reg=__uint_as_float(rr[0])+__uint_as_float(rr[1]);}
  if(hie==0)wsf[32+r32e]=l_reg;asm volatile("s_waitcnt lgkmcnt(0)":::"memory");
  float rli[16];
  #pragma unroll
  for(int r=0;r<16;++r)rli[r]=__builtin_amdgcn_rcpf(wsf[32+crow(r,hie)]);
  bf16*Ow=O+(rowbase+q0+wid*QBLK)*PO;
  bf16*stg=(bf16*)(shm+LDS_OST)+wid*2048;
  if(half==0){
    PREF_NEXT();
    #pragma unroll
    for(int dh=0;dh<2;++dh){
      #pragma unroll
      for(int r=0;r<16;++r){const int orow=crow(r,hie);
        #pragma unroll
        for(int d0=0;d0<2;++d0)stg[orow*64+d0*32+r32e]=__float2bfloat16(o[2*dh+d0][r]*rli[r]);}
      asm volatile("s_waitcnt lgkmcnt(0)":::"memory");
      #pragma unroll
      for(int i=0;i<4;++i){const int row=i*8+(lane_e>>3),ch=lane_e&7; const u32x4 v=*(const u32x4*)(stg+row*64+ch*8); ATTN_STORE16(Ow+(long)row*PO+dh*64+ch*8,v);}
      asm volatile("s_waitcnt lgkmcnt(0)":::"memory"); }
  } else {
    float ssr[16];
    #pragma unroll
    for(int r=0;r<16;++r)ssr[r]=0.f;
    asm volatile("s_waitcnt vmcnt(0)":::"memory");
    #pragma unroll
    for(int dh=0;dh<2;++dh){
      #pragma unroll
      for(int i=0;i<4;++i){const int row=i*8+(lane_e>>3),ch=lane_e&7; const u32x4 v=*(const u32x4*)(Ow+(long)row*PO+dh*64+ch*8); *(u32x4*)(stg+row*64+ch*8)=v;}
      asm volatile("s_waitcnt vmcnt(0) lgkmcnt(0)":::"memory");
      #pragma unroll
      for(int r=0;r<16;++r){const int orow=crow(r,hie);
        #pragma unroll
        for(int d0=0;d0<2;++d0){const float o1=__bfloat162float(stg[orow*64+d0*32+r32e]); const float d=o1-lam*(o[2*dh+d0][r]*rli[r]); o[2*dh+d0][r]=d; ssr[r]+=d*d;}}
      asm volatile("s_waitcnt lgkmcnt(0)":::"memory"); }
    PREF_NEXT();
    #pragma unroll
    for(int r=0;r<16;++r){
      #pragma unroll
      for(int mk=1;mk<32;mk<<=1)ssr[r]+=__int_as_float(__builtin_amdgcn_ds_bpermute((lane_e^mk)<<2,__float_as_int(ssr[r])));
      ssr[r]=__builtin_amdgcn_rsqf(ssr[r]*(1.0f/128.0f)+1e-6f)*post;}
    float gsub[4];
    #pragma unroll
    for(int d0=0;d0<4;++d0)gsub[d0]=subg[d0*32+r32e];
    bf16*Yw=Yc+(rowbase+q0+wid*QBLK)*PY;
    #pragma unroll
    for(int dh=0;dh<2;++dh){
      #pragma unroll
      for(int r=0;r<16;++r){const int orow=crow(r,hie);
        #pragma unroll
        for(int d0=0;d0<2;++d0)stg[orow*64+d0*32+r32e]=__float2bfloat16(o[2*dh+d0][r]*ssr[r]*gsub[2*dh+d0]);}
      asm volatile("s_waitcnt lgkmcnt(0)":::"memory");
      #pragma unroll
      for(int i=0;i<4;++i){const int row=i*8+(lane_e>>3),ch=lane_e&7; const u32x4 v=*(const u32x4*)(stg+row*64+ch*8); ATTN_STORE16(Yw+(long)row*PY+dh*64+ch*8,v);}
      asm volatile("s_waitcnt lgkmcnt(0)":::"memory"); }
  }
  asm volatile("s_waitcnt lgkmcnt(0)":::"memory");
  #undef PREF_NEXT
  #undef DMA_K
  #undef DMA_V
  #undef CMASK
  #undef ROT
}
constexpr int ATTN_LDS_BYTES=LDS_BYTES;
struct AttnTensors { const bf16* QKV; bf16* O; bf16* Y; const float* subg; float lam, post; };
struct AttnUnit { int bh; int qb; int half; };
struct StaticOrder {
  int vcu;
  __device__ __forceinline__ explicit StaticOrder(int grid,int block):vcu((block%8)*(grid/8)+block/8){}
  __device__ __forceinline__ bool next(int i,AttnUnit&u)const{ if(i>=4)return false; const int s=vcu&15; u.bh=vcu>>4; u.qb=(i<2)?s:31-s; u.half=i&1; return true; }
};
template<class Sched,int THRL=8> __device__ __forceinline__ void attn_phase(char*lds,const AttnTensors&T,const Sched&S,const int tid_in){
  AttnUnit u,n; int tid=tid_in; asm volatile("":"+v"(tid));
  bool have=S.next(0,u),pre=false;
  for(int i=0;have;++i){
    const bool hn=S.next(i+1,n);
    const int b=u.bh>>2,h=u.bh&3,half=u.half;
    long dK=0,dV=0;
    if(hn){ const int nb=n.bh>>2,nh=n.bh&3; dK=(long)(nb-b)*SEQ*PQ+(nh-h)*128+(n.half-half)*64; dV=(long)(nb-b)*SEQ*PQ+(nh-h)*128; }
    attn_unit<THRL>(b,u.qb,T.QKV+2048+h*128+half*64,T.QKV+2560+h*128+half*64,T.QKV+3072+h*128,T.O+h*256,lds,tid,half,T.lam,T.post,T.subg,T.Y+1024+h*128,hn,dK,dV,pre);
    pre=hn; u=n; have=hn; }
}
#undef SBAR
#undef WAIT_BAR
}
#include <hip/hip_cooperative_groups.h>
namespace cg = cooperative_groups;
constexpr int NWAVES = 8;
#ifndef MK_SPLIT
#define MK_SPLIT 0
#endif
constexpr int NB = 4, SEQ = 8192, T = NB * SEQ, D = 1024, DIN = 6656, MIXW = 512, FF = 4096, PLE = 256, NL = 2;
constexpr int P1W = 3584, GTW = 3072, YW = 1536;
constexpr int PH_PER_LAYER = 12, NPHASE = NL * PH_PER_LAYER;
constexpr float EPS = 1e-6f;
constexpr float QSCALE = 0.125f * 1.4426950408889634f;

constexpr size_t MiB = 1u << 20;
constexpr size_t WS_WIN = 1 * MiB, WS_WM = 14 * MiB, WS_WO = 17 * MiB, WS_WUP = 19 * MiB, WS_WDN = 27 * MiB, WS_WG = 35 * MiB, WS_WP = 37 * MiB;
constexpr size_t WS_XB = 38 * MiB;
constexpr size_t WS_P1 = 102 * MiB;
constexpr size_t WS_Y = 326 * MiB;
constexpr size_t WS_O = 422 * MiB;
constexpr size_t WS_PB = 486 * MiB;
constexpr size_t WS_SSP = 502 * MiB;
constexpr size_t WS_SSX = 510 * MiB;
constexpr size_t WS_END = 512 * MiB;
constexpr size_t WS_UP = 102 * MiB;
static_assert(WS_XB + (size_t)T * D * 2 <= WS_P1 && WS_P1 + (size_t)T * P1W * 2 <= WS_Y && WS_Y + (size_t)T * YW * 2 <= WS_O && WS_O + (size_t)T * D * 2 <= WS_PB && WS_PB + (size_t)T * PLE * 2 <= WS_END, "ws map");
static_assert(WS_UP + (size_t)T * FF * 2 <= WS_O && WS_WP + (size_t)D * PLE * 2 <= WS_XB && WS_WIN + (size_t)DIN * D * 2 <= WS_WM, "ws map 2");

constexpr int RING_BYTES = 131072, LDS_BYTES = 147456;

#define GAS __attribute__((address_space(1)))
#define LAS __attribute__((address_space(3)))
typedef unsigned short bf16;
typedef unsigned v4u __attribute__((ext_vector_type(4)));
typedef unsigned v2u __attribute__((ext_vector_type(2)));
typedef float f32x4 __attribute__((ext_vector_type(4)));
#define LDS_WAIT() asm volatile("s_waitcnt lgkmcnt(0)" ::: "memory")
__device__ __forceinline__ unsigned f2bf(float f) { unsigned u = __builtin_bit_cast(unsigned, f); return (u + 0x7fffu + ((u >> 16) & 1u)) >> 16; }
__device__ __forceinline__ unsigned pk2(float lo, float hi) { return f2bf(lo) | (f2bf(hi) << 16); }
__device__ __forceinline__ float shx(float v, int m, int lane) { return __int_as_float(__builtin_amdgcn_ds_bpermute((lane ^ m) << 2, __float_as_int(v))); }
__device__ __forceinline__ float wave_sum(float v, int lane) {
#pragma unroll
    for (int o = 1; o < 64; o <<= 1) v += shx(v, o, lane);
    return v;
}
__device__ __forceinline__ void up8(const v4u w, float (&f)[8]) {
#pragma unroll
    for (int i = 0; i < 4; ++i) { f[2 * i] = __uint_as_float(w[i] << 16); f[2 * i + 1] = __uint_as_float(w[i] & 0xffff0000u); }
}
__device__ __forceinline__ v4u pk8(const float (&f)[8]) { v4u w; w.x = pk2(f[0], f[1]); w.y = pk2(f[2], f[3]); w.z = pk2(f[4], f[5]); w.w = pk2(f[6], f[7]); return w; }

#define RLX_AGENT __ATOMIC_RELAXED, __HIP_MEMORY_SCOPE_AGENT
constexpr int CW_BAR = 4096;
constexpr size_t CTL_ZERO_BYTES = 1u << 20, WS_SS = 65536;
constexpr int MISC_OFF = RING_BYTES + 320;
#define XB_TMO      128
#define XB_XCNT(j)  (256  + 64 * (j))
#define XB_XSUB(j)  (1280 + 64 * (j))
#define XB_XGEN(j)  (2304 + 64 * (j))
#define XB_TOP      3328
#define XB_TOPGEN   3392
#define XCD_BAR_WORDS 3456
#define XB_SPIN_CAP (1u << 18)

__device__ __forceinline__ unsigned xb_ld(unsigned* p)              { return __hip_atomic_load(p, __ATOMIC_RELAXED, __HIP_MEMORY_SCOPE_AGENT); }
__device__ __forceinline__ unsigned xb_add(unsigned* p, unsigned v) { return __hip_atomic_fetch_add(p, v, __ATOMIC_RELAXED, __HIP_MEMORY_SCOPE_AGENT); }
__device__ __forceinline__ unsigned xb_xcc_id() { return (unsigned)__builtin_amdgcn_s_getreg((3 << 11) | 20) & 0xFu; }
#define XB_SPIN(cond, bar) do { unsigned _sp = 0; while (cond) { __builtin_amdgcn_s_sleep(1); \
    if ((++_sp & 255u) == 0u) { if (xb_ld(&(bar)[XB_TMO])) break; if (_sp > XB_SPIN_CAP) { atomicAdd(&(bar)[XB_TMO], 1u); break; } } } } while (0)

struct XcdBarrier {
    unsigned* bar; unsigned x;
    volatile LAS unsigned* st;
};

__device__ __forceinline__ XcdBarrier xcd_barrier_post(unsigned* bar, volatile LAS unsigned* st) {
    XcdBarrier b; b.bar = bar; b.x = xb_xcc_id(); b.st = st;
    if (threadIdx.x == 0) (void)xb_add(&bar[XB_XCNT(b.x)], 1u);
    return b;
}
__device__ __forceinline__ void xcd_barrier_complete(unsigned* bar, unsigned x, unsigned& nloc, unsigned& nx) {
    const unsigned G = gridDim.x * gridDim.y * gridDim.z;
    unsigned sum, cnt, mine, sp = 0u;
    for (;;) {
        sum = 0u; cnt = 0u; mine = 0u;
#pragma unroll
        for (unsigned j = 0; j < 16; ++j) { const unsigned c = xb_ld(&bar[XB_XCNT(j)]); sum += c; cnt += (c > 0u) ? 1u : 0u; mine = (j == x) ? c : mine; }
        if (sum == G) break;
        __builtin_amdgcn_s_sleep(1);
        if ((++sp & 255u) == 0u) { if (xb_ld(&bar[XB_TMO])) break; if (sp > XB_SPIN_CAP) { atomicAdd(&bar[XB_TMO], 1u); break; } }
    }
    nloc = mine > 0u ? mine : 1u; nx = cnt > 0u ? cnt : 1u;
}

__device__ __forceinline__ void xcd_barrier(const XcdBarrier& b, const bool leader) {
    asm volatile("s_waitcnt vmcnt(0)" ::: "memory");
    __syncthreads();
    if (leader) {
        unsigned* bar = b.bar;
        __builtin_amdgcn_s_waitcnt(0);
        unsigned nloc = b.st[0], nx = b.st[1];
        if (nloc == 0u) { xcd_barrier_complete(bar, b.x, nloc, nx); b.st[0] = nloc; b.st[1] = nx; }
        const unsigned old = xb_add(&bar[XB_XSUB(b.x)], 1u);
        const unsigned gen = old / nloc;
        if (old + 1u == (gen + 1u) * nloc) {
            __builtin_amdgcn_fence(__ATOMIC_RELEASE, "agent");
            asm volatile("s_waitcnt vmcnt(0)" ::: "memory");
            const unsigned og = xb_add(&bar[XB_TOP], 1u);
            const unsigned tg = og / nx;
            if (og + 1u == (tg + 1u) * nx) xb_add(&bar[XB_TOPGEN], 1u);
            else XB_SPIN(xb_ld(&bar[XB_TOPGEN]) == tg, bar);
            __builtin_amdgcn_fence(__ATOMIC_ACQUIRE, "agent");
            xb_add(&bar[XB_XGEN(b.x)], 1u);
            asm volatile("s_waitcnt vmcnt(0)" ::: "memory");
        } else {
            XB_SPIN(xb_ld(&bar[XB_XGEN(b.x)]) == gen, bar);
            __builtin_amdgcn_fence(__ATOMIC_ACQUIRE, "agent");
            asm volatile("s_waitcnt vmcnt(0)" ::: "memory");
        }
    }
    __syncthreads();
}

__device__ __forceinline__ void p0_transpose_item(const float* W, int K, int N, bf16* WT, LAS float* scr, int item, int lane, const float* gk = nullptr, const bool permqk = false) {
    const int nblk = N / 32, kb = item / nblk, nb = item % nblk, k0 = 64 * kb, n0 = 32 * nb;
    float wv[32];
#pragma unroll
    for (int i = 0; i < 32; ++i) wv[i] = W[(size_t)(k0 + 2 * i + (lane >> 5)) * N + n0 + (lane & 31)] * (gk ? gk[k0 + 2 * i + (lane >> 5)] : 1.f);
#pragma unroll
    for (int i = 0; i < 32; ++i) scr[(2 * i + (lane >> 5)) * 33 + (lane & 31)] = wv[i];
    LDS_WAIT(); asm volatile("" ::: "memory");
    const int c = lane & 7;
    int nout0 = n0; if (permqk && n0 >= 2048 && n0 < 3072) { const int lb = (n0 >> 5) & 7; nout0 = (n0 & ~255) + (((lb & 1) * 4 + (lb >> 1)) << 5); }
#pragma unroll
    for (int j = 0; j < 4; ++j) { const int n = (lane >> 3) + 8 * j; const LAS float* s = scr + (8 * c) * 33 + n;
        v4u o; o.x = pk2(s[0 * 33], s[1 * 33]); o.y = pk2(s[2 * 33], s[3 * 33]); o.z = pk2(s[4 * 33], s[5 * 33]); o.w = pk2(s[6 * 33], s[7 * 33]);
        *(v4u*)(WT + (size_t)(nout0 + n) * K + k0 + 8 * c) = o; }
    LDS_WAIT(); asm volatile("" ::: "memory");
}
__device__ __forceinline__ void row_to_bf16_ss(const float* xrow, bf16* orow, float* ssp, int lane) {
    const f32x4* xr = (const f32x4*)xrow + lane;
    f32x4 v[4]; float s = 0.f;
#pragma unroll
    for (int j = 0; j < 4; ++j) { v[j] = xr[64 * j]; s += (v[j].x * v[j].x + v[j].y * v[j].y) + (v[j].z * v[j].z + v[j].w * v[j].w); }
    s = wave_sum(s, lane);
    v2u* o8 = (v2u*)orow + lane;
#pragma unroll
    for (int j = 0; j < 4; ++j) { v2u o; o.x = pk2(v[j].x, v[j].y); o.y = pk2(v[j].z, v[j].w); o8[64 * j] = o; }
    if (lane == 0) *ssp = s;
}
__device__ __forceinline__ void rms_row_to_bf16(const float* xrow, const float* g, bf16* orow, int lane) {
    const f32x4* xr = (const f32x4*)xrow + lane; const f32x4* gr = (const f32x4*)g + lane;
    f32x4 v[4]; float s = 0.f;
#pragma unroll
    for (int j = 0; j < 4; ++j) { v[j] = xr[64 * j]; s += (v[j].x * v[j].x + v[j].y * v[j].y) + (v[j].z * v[j].z + v[j].w * v[j].w); }
    const float rstd = 1.f / sqrtf(wave_sum(s, lane) * (1.f / D) + EPS);
    v2u* o8 = (v2u*)orow + lane;
#pragma unroll
    for (int j = 0; j < 4; ++j) { const f32x4 gv = gr[64 * j]; v2u o; o.x = pk2(v[j].x * rstd * gv.x, v[j].y * rstd * gv.y); o.y = pk2(v[j].z * rstd * gv.z, v[j].w * rstd * gv.w); o8[64 * j] = o; }
}

struct Args { const float* in[24]; float* out; unsigned char* ws; int ph_lo, ph_hi; };

__global__ void __launch_bounds__(NWAVES * 64, 2) fwd_mega(Args args) {
    extern __shared__ __attribute__((aligned(16))) unsigned char lds[];
    cg::grid_group grid = cg::this_grid();
#define PH_BEGIN \
    int tid = MYTID(); asm volatile("" : "+v"(tid)); \
    int G = gridDim.x, bx = blockIdx.x; asm volatile("" : "+s"(G), "+s"(bx)); \
    unsigned char* ws = args.ws; float* out = args.out; asm volatile("" : "+s"(ws), "+s"(out)); \
    const int lane = tid & 63, wave = __builtin_amdgcn_readfirstlane(tid >> 6); \
    const int vcu = (bx % 8) * (G / 8) + bx / 8; \
    const int gw = vcu * NWAVES + wave, NGW = G * NWAVES, gt = vcu * (NWAVES * 64) + tid, NGT = G * NWAVES * 64; \
    LAS unsigned char* ldsp = (LAS unsigned char*)lds; \
    (void)lane; (void)gw; (void)NGW; (void)gt; (void)NGT; (void)ldsp; (void)out; (void)ws;
#define Win_t ((bf16*)(ws + WS_WIN))
#define WM_t ((bf16*)(ws + WS_WM))
#define Wo_t ((bf16*)(ws + WS_WO))
#define Wup_t ((bf16*)(ws + WS_WUP))
#define Wdn_t ((bf16*)(ws + WS_WDN))
#define Wg_t ((bf16*)(ws + WS_WG))
#define Wp_t ((bf16*)(ws + WS_WP))
#define XB ((bf16*)(ws + ((L & 1) ? WS_O : WS_XB)))
#define P1 ((bf16*)(ws + WS_P1))
#define Yb ((bf16*)(ws + WS_Y))
#define Ob ((bf16*)(ws + ((L & 1) ? WS_XB : WS_O)))
#define PB ((bf16*)(ws + WS_PB))
#define UP ((bf16*)(ws + WS_UP))
    const int wave_s = __builtin_amdgcn_readfirstlane((int)threadIdx.x >> 6);
#define MYTID() ({ unsigned z_; asm volatile("v_mov_b32 %0, 0" : "=v"(z_)); wave_s * 64 + (int)__builtin_amdgcn_mbcnt_hi(~0u, __builtin_amdgcn_mbcnt_lo(~0u, z_)); })
    volatile LAS unsigned* MISC = (volatile LAS unsigned*)((LAS unsigned char*)lds + MISC_OFF);
    if (threadIdx.x < 32) MISC[threadIdx.x] = 0u;
    __syncthreads();
    const int lo = args.ph_lo, hi = args.ph_hi;
    if (lo == 0) {
        unsigned char* ws0 = args.ws;
        if (blockIdx.x == 0) for (int i = threadIdx.x; i < XCD_BAR_WORDS; i += NWAVES * 64) ((unsigned*)ws0 + CW_BAR)[i] = 0u;
    }
#define IN(k) (lo <= (k) && (k) < hi)
#ifndef PHMASK
#define PHMASK 0xfff
#endif
#define PH_ON(j) (((PHMASK) >> (j)) & 1)
#define SEAM(k) do { if (IN(k) && IN((k) + 1)) { if ((k) == 0) { asm volatile("s_waitcnt vmcnt(0)" ::: "memory"); __syncthreads(); grid.sync(); (void)xcd_barrier_post((unsigned*)args.ws + CW_BAR, (volatile LAS unsigned*)((LAS unsigned char*)lds + MISC_OFF) + 8); } else { XcdBarrier bar_; bar_.bar = (unsigned*)args.ws + CW_BAR; bar_.x = xb_xcc_id(); bar_.st = (volatile LAS unsigned*)((LAS unsigned char*)lds + MISC_OFF) + 8; xcd_barrier(bar_, MYTID() == 0); } } } while (0)

    for (int L = 0; L < NL; ++L) {
        const int pb = L * PH_PER_LAYER;
#define LP(idx, stride) (args.in[idx] + (size_t)L * (stride))
#define hsrc ((L == 0) ? args.in[0] : (const float*)out)
#define SSP0 ((float*)(ws + WS_SS) + (size_t)L * T)
#define SSP(j) ((float*)(ws + WS_SSP) + (size_t)(2 * L + (j) - 1) * T * 16)
#define p_in LP(1, (size_t)T * PLE)
#define g_mix LP(2, D)
#define w_in LP(3, (size_t)D * DIN)
#define pool_w LP(4, 4 * 128 * 128)
#define pool_scale LP(5, MIXW)
#define conv_w LP(6, 3 * MIXW)
#define qg LP(7, 64)
#define kg LP(8, 64)
#define lq1 LP(9, 64)
#define lk1 LP(10, 64)
#define lq2 LP(11, 64)
#define lk2 LP(12, 64)
#define subg LP(13, 128)
#define w_pool_out LP(14, (size_t)MIXW * D)
#define w_conv_out LP(15, (size_t)MIXW * D)
#define w_attn_out LP(16, (size_t)MIXW * D)
#define w_o LP(17, (size_t)D * D)
#define g_mlp LP(18, D)
#define w_up LP(19, (size_t)D * FF)
#define w_down LP(20, (size_t)FF * D)
#define g_ple LP(21, D)
#define w_gate LP(22, (size_t)D * D)
#define w_proj LP(23, (size_t)PLE * D)
        const float lam_init = (L == 0) ? 0.2f : 0.35550906759096940f;

        if (PH_ON(0) && IN(pb + 0)) { PH_BEGIN
            {
                const int n = gt & 1023, kgrp = __builtin_amdgcn_readfirstlane(gt >> 10), k0 = kgrp * 4, gI = k0 >> 7;
                const float* wp = w_pool_out + (size_t)(gI * 128) * D + n; const float* sc = pool_scale + gI * 128; const float* pw = pool_w + (size_t)k0 * 128;
                float a[8];
#pragma unroll
                for (int j = 0; j < 8; ++j) a[j] = 0.f;
                for (int d0 = 0; d0 < 128; d0 += 8) {
                    float w[8];
#pragma unroll
                    for (int dd = 0; dd < 8; ++dd) w[dd] = wp[(size_t)(d0 + dd) * D];
#pragma unroll
                    for (int dd = 0; dd < 8; ++dd) w[dd] *= sc[d0 + dd];
#pragma unroll
                    for (int j = 0; j < 4; ++j)
#pragma unroll
                        for (int dd = 0; dd < 8; ++dd) a[j] += pw[j * 128 + d0 + dd] * w[dd];
                }
                v2u o; o.x = pk2(a[0], a[1]); o.y = pk2(a[2], a[3]);
                if (gt < 131072) *(v2u*)(WM_t + (size_t)n * MIXW + k0) = o;
            }
            LAS float* scr = (LAS float*)((LAS unsigned char*)lds + wave * 16384);
            constexpr int I_IN = (D / 64) * (DIN / 32), I_M = (MIXW / 64) * (D / 32), I_O = (D / 64) * (D / 32), I_UP = (D / 64) * (FF / 32), I_DN = (FF / 64) * (D / 32), I_P = (PLE / 64) * (D / 32);
            constexpr int NITEMS = I_IN + 2 * I_M + 2 * I_O + I_UP + I_DN + I_P;
            for (int it = gw; it < NITEMS; it += NGW) {
                int r = it;
                if (r < I_IN) { p0_transpose_item(w_in, D, DIN, Win_t, scr, r, lane, g_mix, true); continue; } r -= I_IN;
                if (r < I_M) { p0_transpose_item(w_conv_out, MIXW, D, WM_t + (size_t)D * MIXW, scr, r, lane); continue; } r -= I_M;
                if (r < I_M) { p0_transpose_item(w_attn_out, MIXW, D, WM_t + (size_t)2 * D * MIXW, scr, r, lane); continue; } r -= I_M;
                if (r < I_O) { p0_transpose_item(w_o, D, D, Wo_t, scr, r, lane); continue; } r -= I_O;
                if (r < I_O) { p0_transpose_item(w_gate, D, D, Wg_t, scr, r, lane, g_ple); continue; } r -= I_O;
                if (r < I_UP) { p0_transpose_item(w_up, D, FF, Wup_t, scr, r, lane, g_mlp); continue; } r -= I_UP;
                if (r < I_DN) { p0_transpose_item(w_down, FF, D, Wdn_t, scr, r, lane); continue; } r -= I_DN;
                p0_transpose_item(w_proj, PLE, D, Wp_t, scr, r, lane);
            }
            if (L == 0) { for (int m = gw; m < T; m += NGW) row_to_bf16_ss(hsrc + (size_t)m * D, XB + (size_t)m * D, SSP0 + m, lane); }
            else { for (int m = gt; m < T; m += NGT) SSP0[m] = pg8::sum16((const float*)(ws + WS_SSX) + (size_t)m * 16); }
            for (int c = gt; c < T * PLE / 8; c += NGT) { const f32x4 a = *(const f32x4*)(p_in + (size_t)c * 8), b = *(const f32x4*)(p_in + (size_t)c * 8 + 4);
                v4u o; o.x = pk2(a.x, a.y); o.y = pk2(a.z, a.w); o.z = pk2(b.x, b.y); o.w = pk2(b.z, b.w); *(v4u*)(PB + (size_t)c * 8) = o; }
            __syncthreads();
        }
        SEAM(pb + 0);

        if (PH_ON(1) && IN(pb + 1)) { PH_BEGIN
            pg8::Gemm g{XB, Win_t, T, P1W, D, D, D}; pg8::StaticOrder S; S.init(T, P1W, G, bx);
            pg8::EpiAct<0, 1> E{P1, P1W, SSP0, qg, kg, QSCALE};
            pg8::gemm_phase<pg8::EpiAct<0, 1>, pg8::StaticOrder, true, true>(ldsp, g, S, E, tid);
        }
        SEAM(pb + 1);

        if (PH_ON(3) && IN(pb + 3)) { PH_BEGIN
            const float s1 = wave_sum(lq1[lane] * lk1[lane], lane), s2 = wave_sum(lq2[lane] * lk2[lane], lane);
            const float lam = __expf(s1) - __expf(s2) + lam_init;
            const attn_body::AttnTensors AT{(const attn_body::bf16*)P1, (attn_body::bf16*)Ob, (attn_body::bf16*)Yb, subg, lam, 1.f - lam_init};
            const attn_body::StaticOrder S(G, bx);
            attn_body::attn_phase<attn_body::StaticOrder>((char*)lds, AT, S, tid);
        }
        if (PH_ON(2) && IN(pb + 2)) { PH_BEGIN
            const int c8 = 8 * lane, grp = lane >> 4;
            const int win = 2 << grp;
            float cw[3][8];
#pragma unroll
            for (int j = 0; j < 3; ++j) { const f32x4 w0 = *(const f32x4*)(conv_w + (2 - j) * MIXW + c8), w1 = *(const f32x4*)(conv_w + (2 - j) * MIXW + c8 + 4);
                cw[j][0] = w0.x; cw[j][1] = w0.y; cw[j][2] = w0.z; cw[j][3] = w0.w; cw[j][4] = w1.x; cw[j][5] = w1.y; cw[j][6] = w1.z; cw[j][7] = w1.w; }
            const int t0 = vcu * 128 + wave * 16, s0 = t0 & (SEQ - 1);
            const bf16* base = P1 + (size_t)t0 * P1W;
            const float hv = (s0 == 0) ? 0.f : 1.f;
            {
                v4u pa[31];
#pragma unroll
                for (int i = 0; i < 31; ++i) { const bool ok = (i >= 15) || (s0 != 0); pa[i] = *(const v4u*)(base + (ok ? (ptrdiff_t)(i - 15) * P1W : (ptrdiff_t)0) + c8); }
                float W[8], v[8];
#pragma unroll
                for (int e = 0; e < 8; ++e) W[e] = 0.f;
#pragma unroll
                for (int j = 1; j < 16; ++j) { const float mj = (j < win) ? hv : 0.f; up8(pa[15 - j], v);
#pragma unroll
                    for (int e = 0; e < 8; ++e) W[e] += mj * v[e]; }
#pragma unroll
                for (int r = 0; r < 16; ++r) {
                    float cur[8]; up8(pa[15 + r], cur);
#pragma unroll
                    for (int e = 0; e < 8; ++e) W[e] += cur[e];
                    if (r >= 1) {
                        v4u sel;
#pragma unroll
                        for (int q = 0; q < 4; ++q) { const unsigned x2 = pa[13 + r][q], x4 = (r + 11 >= 0 && r + 11 < 31) ? pa[11 + r][q] : 0u, x8 = pa[7 + r][q], x16 = pa[r - 1][q];
                            sel[q] = (grp == 0) ? x2 : (grp == 1) ? x4 : (grp == 2) ? x8 : x16; }
                        const float ml = (r >= win) ? 1.f : hv; up8(sel, v);
#pragma unroll
                        for (int e = 0; e < 8; ++e) W[e] -= ml * v[e];
                    }
                    const int sp1 = s0 + r + 1; const float inv = 1.f / (float)((sp1 < win) ? sp1 : win);
                    float o[8];
#pragma unroll
                    for (int e = 0; e < 8; ++e) o[e] = W[e] * inv - cur[e];
                    *(v4u*)(Yb + (size_t)(t0 + r) * YW + c8) = pk8(o);
                }
            }
            {
                float z1[8], z2[8], cx[8], cc[8];
                {   const v4u a1 = *(const v4u*)(base - (s0 != 0 ? (ptrdiff_t)P1W : (ptrdiff_t)0) + 512 + c8), b1 = *(const v4u*)(base - (s0 != 0 ? (ptrdiff_t)P1W : (ptrdiff_t)0) + 1536 + c8);
                    const v4u a2 = *(const v4u*)(base - (s0 != 0 ? (ptrdiff_t)2 * P1W : (ptrdiff_t)0) + 512 + c8), b2 = *(const v4u*)(base - (s0 != 0 ? (ptrdiff_t)2 * P1W : (ptrdiff_t)0) + 1536 + c8);
                    up8(a1, cx); up8(b1, cc);
#pragma unroll
                    for (int e = 0; e < 8; ++e) z1[e] = hv * cc[e] * cx[e];
                    up8(a2, cx); up8(b2, cc);
#pragma unroll
                    for (int e = 0; e < 8; ++e) z2[e] = hv * cc[e] * cx[e]; }
#pragma unroll
                for (int rb = 0; rb < 16; rb += 8) {
                    v4u xv[8], cv[8], bv[8];
#pragma unroll
                    for (int i = 0; i < 8; ++i) { const bf16* pr = base + (size_t)(rb + i) * P1W; xv[i] = *(const v4u*)(pr + 512 + c8); bv[i] = *(const v4u*)(pr + 1024 + c8); cv[i] = *(const v4u*)(pr + 1536 + c8); }
#pragma unroll
                    for (int i = 0; i < 8; ++i) { float z0[8], cb[8], o[8]; up8(xv[i], cx); up8(cv[i], cc); up8(bv[i], cb);
#pragma unroll
                        for (int e = 0; e < 8; ++e) { z0[e] = cc[e] * cx[e]; o[e] = cb[e] * (cw[0][e] * z0[e] + cw[1][e] * z1[e] + cw[2][e] * z2[e]); z2[e] = z1[e]; z1[e] = z0[e]; }
                        *(v4u*)(Yb + (size_t)(t0 + rb + i) * YW + 512 + c8) = pk8(o); }
                }
            }
        }

        SEAM(pb + 3);

        if (PH_ON(4) && IN(pb + 4)) { PH_BEGIN
            pg8::Gemm g{XB, Win_t + (size_t)P1W * D, T, GTW, D, D, D}; pg8::StaticOrder S; S.init(T, GTW, G, bx);
            pg8::EpiAct<1, 1> E{P1, GTW, SSP0};
            pg8::gemm_phase<pg8::EpiAct<1, 1>, pg8::StaticOrder, true, true>(ldsp, g, S, E, tid);
        }
        SEAM(pb + 4);

        if (PH_ON(5) && IN(pb + 5)) { PH_BEGIN
            pg8::SegOrder S; S.base.init(T, D, G, bx);
            pg8::Gemm g{Yb, WM_t, T, D, MIXW, YW, MIXW, (size_t)MIXW * 2, (size_t)D * MIXW * 2};
            pg8::EpiMergeR E{P1, Ob};
            pg8::gemm_phase<pg8::EpiMergeR, pg8::SegOrder, true, true>(ldsp, g, S, E, tid);
        }
        SEAM(pb + 5);

        if (PH_ON(6) && IN(pb + 6)) { PH_BEGIN
            pg8::Gemm g{Ob, Wo_t, T, D, D, D, D}; pg8::StaticOrder S; S.init(T, D, G, bx);
            pg8::EpiResidN E{(L == 0) ? args.in[0] : (const float*)nullptr, XB, SSP(1)};
            pg8::gemm_phase<pg8::EpiResidN, pg8::StaticOrder, true, true>(ldsp, g, S, E, tid);
        }
        SEAM(pb + 6);


        if (PH_ON(8) && IN(pb + 8)) { PH_BEGIN
            { pg8::Gemm g{PB, Wp_t, T, D, PLE, PLE, PLE}; pg8::StaticOrder S; S.init(T, D, G, bx);
              pg8::EpiAct<0, 0> E{Ob, D, nullptr};
              pg8::gemm_phase<pg8::EpiAct<0, 0>, pg8::StaticOrder, true, true>(ldsp, g, S, E, tid); }
            pg8::Gemm g{XB, Wup_t, T, FF, D, D, D}; pg8::StaticOrder S; S.init(T, FF, G, bx);
            pg8::EpiAct<2, 2> E{UP, FF, SSP(1)};
            pg8::gemm_phase<pg8::EpiAct<2, 2>, pg8::StaticOrder, true, true>(ldsp, g, S, E, tid);
        }
        SEAM(pb + 8);

        if (PH_ON(9) && IN(pb + 9)) { PH_BEGIN
            pg8::Gemm g{UP, Wdn_t, T, D, FF, FF, FF}; pg8::StaticOrder S; S.init(T, D, G, bx);
            pg8::EpiResidN E{nullptr, XB, SSP(2)};
            pg8::gemm_phase<pg8::EpiResidN, pg8::StaticOrder, true, true>(ldsp, g, S, E, tid);
        }
        SEAM(pb + 9);


        if (PH_ON(11) && IN(pb + 11)) { PH_BEGIN
            pg8::Gemm g{XB, Wg_t, T, D, D, D, D}; pg8::StaticOrder S; S.init(T, D, G, bx);
            pg8::EpiPle E{XB, (L == NL - 1) ? out : (float*)nullptr, Ob, SSP(2), (float*)(ws + WS_SSX)};
            pg8::gemm_phase<pg8::EpiPle, pg8::StaticOrder, true, true>(ldsp, g, S, E, tid);
        }
        SEAM(pb + 11);
    }
#undef IN
#undef SEAM
}

extern "C" void kernel_launch(void* const* d_in, const int* in_sizes, int n_in, void* d_out, int out_size, void* d_ws, size_t ws_size, hipStream_t stream) {
    static int grid = 0;
    if (grid == 0) {
        if (n_in != 24 || in_sizes[0] != T * D || out_size != T * D || ws_size < WS_END) { fprintf(stderr, "kernel_launch: unexpected shapes / workspace (n_in %d, in0 %d, out %d, ws %zu < %zu); nothing launched\n", n_in, n_in > 0 ? in_sizes[0] : -1, out_size, ws_size, (size_t)WS_END); grid = -1; return; }
        int dev = 0, cus = 0, per_cu = 0;
        if (hipGetDevice(&dev) != hipSuccess || hipDeviceGetAttribute(&cus, hipDeviceAttributeMultiprocessorCount, dev) != hipSuccess) { grid = -1; return; }
        if (hipFuncSetAttribute((const void*)fwd_mega, hipFuncAttributeMaxDynamicSharedMemorySize, LDS_BYTES) != hipSuccess) { fprintf(stderr, "kernel_launch: hipFuncSetAttribute failed\n"); grid = -1; return; }
        if (hipOccupancyMaxActiveBlocksPerMultiprocessor(&per_cu, (const void*)fwd_mega, NWAVES * 64, LDS_BYTES) != hipSuccess) per_cu = 0;
        (void)hipGetLastError();
        if (cus * per_cu < 256) { fprintf(stderr, "kernel_launch: resident capacity %d x %d < 256 workgroups; nothing launched\n", cus, per_cu); grid = -1; return; }
        grid = 256;
    }
    if (grid < 0) return;
    Args a{};
    for (int i = 0; i < 24; ++i) a.in[i] = (const float*)d_in[i];
    a.out = (float*)d_out; a.ws = (unsigned char*)d_ws;
#if MK_SPLIT
    for (int ph = 0; ph < NPHASE; ++ph) { a.ph_lo = ph; a.ph_hi = ph + 1; hipLaunchKernelGGL(fwd_mega, dim3(grid), dim3(NWAVES * 64), LDS_BYTES, stream, a); }
#else
    a.ph_lo = 0; a.ph_hi = NPHASE;
    void* kargs[] = {&a};
    const hipError_t e = hipLaunchCooperativeKernel((const void*)fwd_mega, dim3(grid), dim3(NWAVES * 64), kargs, LDS_BYTES, stream);
    if (e != hipSuccess) fprintf(stderr, "kernel_launch: cooperative launch failed: %s\n", hipGetErrorString(e));
#endif
}
```
